# Optimizing an MI355X kernel written in HIP

```python
import jax, jax.numpy as jnp
from jax import lax
import numpy as np

D_MODEL = 1024
BATCH = 32
SEQ = 2048
DEPTH = 2
DEC_BATCH = 8
DEC_SEQ = 4096
PAST_LEN = 128

RET_HEADS = 4
RET_DK = 128
RET_DV = 128
RET_QK_WIDTH = 512
RET_WIDTH = 512
RET_CHUNK = 128
RET_LOG2_FWD = (-5.0, -6.0, -7.0, -8.0)
RET_LOG2_BWD = (-5.5, -6.5, -7.5, -8.5)
MLA_HEADS = 4
MLA_NOPE = 128
MLA_ROPE = 64
MLA_QK = 192
MLA_V = 128
MLA_WIDTH = 512
Q_LORA = 256
KV_LORA = 128
Q_BLOCK = 128
ROPE_BASE = 10000.0
NORM_EPS = 1e-6
IN_SPLITS = (RET_QK_WIDTH, RET_QK_WIDTH, RET_WIDTH, RET_WIDTH, Q_LORA, KV_LORA, MLA_ROPE, MLA_WIDTH, D_MODEL, D_MODEL)
IN_WIDTH = 2 * RET_QK_WIDTH + 2 * RET_WIDTH + Q_LORA + KV_LORA + MLA_ROPE + MLA_WIDTH + 2 * D_MODEL

kernel_name = "hybrid_retention_mla_encoder"


def rms_norm(x, g):
    xf = x.astype(jnp.float32)
    y = xf * lax.rsqrt(jnp.mean(xf * xf, axis=-1, keepdims=True) + NORM_EPS)
    return (y * g.astype(jnp.float32)).astype(x.dtype)


def rope(x):
    S, d = x.shape[1], x.shape[-1]
    inv = ROPE_BASE ** (-jnp.arange(0, d, 2, dtype=jnp.float32) / d)
    ang = jnp.arange(S, dtype=jnp.float32)[:, None] * inv[None, :]
    cos = jnp.cos(ang)[None, :, None, :]
    sin = jnp.sin(ang)[None, :, None, :]
    xf = x.astype(jnp.float32)
    x1, x2 = xf[..., : d // 2], xf[..., d // 2:]
    return jnp.concatenate([x1 * cos - x2 * sin, x1 * sin + x2 * cos], axis=-1).astype(x.dtype)


def retention_dir(q, k, v, log_gamma, include_diag):
    b, L, H, dk = q.shape
    dv = v.shape[-1]
    n = L // RET_CHUNK

    def chunks(t):
        return t.reshape(b, n, RET_CHUNK, H, t.shape[-1]).transpose(1, 0, 3, 2, 4)

    pos = jnp.arange(RET_CHUNK, dtype=jnp.float32)
    diff = pos[:, None] - pos[None, :]
    mask = (diff >= 0) if include_diag else (diff > 0)
    intra_decay = jnp.where(mask, jnp.exp(log_gamma[:, None, None] * jnp.maximum(diff, 0.0)), 0.0)
    xi = jnp.exp(log_gamma[:, None] * (pos + 1.0))[..., None]
    zeta = jnp.exp(log_gamma[:, None] * (RET_CHUNK - 1.0 - pos))[..., None]
    chunk_decay = jnp.exp(log_gamma * RET_CHUNK)[:, None, None]

    def step(state, inp):
        qi, ki, vi = inp
        s = jnp.einsum('bhqd,bhkd->bhqk', qi, ki) * intra_decay
        out = jnp.einsum('bhqk,bhkv->bhqv', s, vi) + jnp.einsum('bhqd,bhdv->bhqv', qi * xi, state)
        state = state * chunk_decay + jnp.einsum('bhkd,bhkv->bhdv', ki * zeta, vi)
        return state, out

    init = jnp.zeros((b, H, dk, dv), jnp.float32)
    _, out = lax.scan(step, init, (chunks(q), chunks(k), chunks(v)))
    return out.transpose(1, 0, 3, 2, 4).reshape(b, L, H, dv)


def mla_attention(q, k, v):
    b, S, H, dq = q.shape
    nb = S // Q_BLOCK
    qb = q.reshape(b, nb, Q_BLOCK, H, dq).transpose(1, 0, 2, 3, 4)
    scale = dq ** -0.5

    def block(qi):
        s = jnp.einsum('bqhd,bkhd->bhqk', qi, k).astype(jnp.float32) * scale
        p = jax.nn.softmax(s, axis=-1)
        return jnp.einsum('bhqk,bkhv->bqhv', p.astype(v.dtype), v)

    o = lax.map(block, qb)
    return o.transpose(1, 0, 2, 3, 4).reshape(b, S, H * MLA_V)


def mixer_layer(x, norm_g, w_in, ret_gn_g, q_norm_g, kv_norm_g, w_uq, w_ukv, w_br_ret, w_br_mla, w_out):
    b, S, _ = x.shape
    h = rms_norm(x, norm_g)
    z = h @ w_in
    idx = [int(i) for i in np.cumsum(IN_SPLITS)[:-1]]
    rq, rk, rv, rg, cq, ckv, kpe, mg, g_ret, g_mla = jnp.split(z, idx, axis=-1)

    rq = rope(rq.reshape(b, S, RET_HEADS, RET_DK)).astype(jnp.float32)
    rk = rope(rk.reshape(b, S, RET_HEADS, RET_DK)).astype(jnp.float32) * (RET_DK ** -0.5)
    rv = rv.reshape(b, S, RET_HEADS, RET_DV).astype(jnp.float32)
    lg_f = jnp.log1p(-jnp.exp2(jnp.array(RET_LOG2_FWD, jnp.float32)))
    lg_b = jnp.log1p(-jnp.exp2(jnp.array(RET_LOG2_BWD, jnp.float32)))
    o_f = retention_dir(rq, rk, rv, lg_f, True)
    o_b = retention_dir(rq[:, ::-1], rk[:, ::-1], rv[:, ::-1], lg_b, False)[:, ::-1]
    o = o_f + o_b
    mu = jnp.mean(o, axis=-1, keepdims=True)
    var = jnp.mean(jnp.square(o - mu), axis=-1, keepdims=True)
    o = ((o - mu) * lax.rsqrt(var + NORM_EPS)).reshape(b, S, RET_WIDTH) * ret_gn_g.astype(jnp.float32)
    ret_out = (o.astype(x.dtype) * jax.nn.silu(rg)) @ w_br_ret

    cq = rms_norm(cq, q_norm_g)
    q = (cq @ w_uq).reshape(b, S, MLA_HEADS, MLA_QK)
    q = jnp.concatenate([q[..., :MLA_NOPE], rope(q[..., MLA_NOPE:])], axis=-1)
    ckv = rms_norm(ckv, kv_norm_g)
    kv = (ckv @ w_ukv).reshape(b, S, MLA_HEADS, MLA_NOPE + MLA_V)
    k_nope, v = kv[..., :MLA_NOPE], kv[..., MLA_NOPE:]
    k_pe = rope(kpe.reshape(b, S, 1, MLA_ROPE))
    k = jnp.concatenate([k_nope, jnp.broadcast_to(k_pe, (b, S, MLA_HEADS, MLA_ROPE))], axis=-1)
    a = mla_attention(q, k, v)
    mla_out = (a * jax.nn.silu(mg)) @ w_br_mla

    merged = jax.nn.sigmoid(g_ret) * ret_out + jax.nn.sigmoid(g_mla) * mla_out
    return x + merged @ w_out


def trunk(x, norm_g, w_in, ret_gn_g, q_norm_g, kv_norm_g, w_uq, w_ukv, w_br_ret, w_br_mla, w_out, final_norm_g):
    for i in range(DEPTH):
        x = mixer_layer(x, norm_g[i], w_in[i], ret_gn_g[i], q_norm_g[i], kv_norm_g[i], w_uq[i], w_ukv[i],
                        w_br_ret[i], w_br_mla[i], w_out[i])
    return rms_norm(x, final_norm_g)


def setup_inputs(seed: int = 0) -> dict:
    key = jax.random.key(seed)
    ks = jax.random.split(key, 16)
    f = jnp.float32

    def nrm(k, shape, fan_in):
        return jax.random.normal(k, shape, f) * (fan_in ** -0.5)

    def gain(k, shape):
        return 1.0 + 0.02 * jax.random.normal(k, shape, f)

    return {
        "x_prompt": jax.random.normal(ks[0], (BATCH, SEQ, D_MODEL), f),
        "x_sample": jax.random.normal(ks[1], (DEC_BATCH, DEC_SEQ, D_MODEL), f),
        "norm_g": gain(ks[2], (DEPTH, D_MODEL)),
        "w_in": nrm(ks[3], (DEPTH, D_MODEL, IN_WIDTH), D_MODEL),
        "ret_gn_g": gain(ks[4], (DEPTH, RET_WIDTH)),
        "q_norm_g": gain(ks[5], (DEPTH, Q_LORA)),
        "kv_norm_g": gain(ks[6], (DEPTH, KV_LORA)),
        "w_uq": nrm(ks[7], (DEPTH, Q_LORA, MLA_HEADS * MLA_QK), Q_LORA),
        "w_ukv": nrm(ks[8], (DEPTH, KV_LORA, MLA_HEADS * (MLA_NOPE + MLA_V)), KV_LORA),
        "w_br_ret": nrm(ks[9], (DEPTH, RET_WIDTH, D_MODEL), RET_WIDTH),
        "w_br_mla": nrm(ks[10], (DEPTH, MLA_WIDTH, D_MODEL), MLA_WIDTH),
        "w_out": nrm(ks[11], (DEPTH, D_MODEL, D_MODEL), D_MODEL),
        "final_norm_g": gain(ks[12], (D_MODEL,)),
    }


def reference(x_prompt, x_sample, norm_g, w_in, ret_gn_g, q_norm_g, kv_norm_g, w_uq, w_ukv, w_br_ret, w_br_mla, w_out, final_norm_g):
    y_prompt = trunk(x_prompt, norm_g, w_in, ret_gn_g, q_norm_g, kv_norm_g, w_uq, w_ukv, w_br_ret, w_br_mla, w_out, final_norm_g)
    y_sample = trunk(x_sample, norm_g, w_in, ret_gn_g, q_norm_g, kv_norm_g, w_uq, w_ukv, w_br_ret, w_br_mla, w_out, final_norm_g)
    return (y_prompt, y_sample)
```

```cpp
#include <hip/hip_runtime.h>
#include <hip/hip_cooperative_groups.h>
#include <cstdio>
#include <cstdint>
namespace cg = cooperative_groups;

#ifndef ONLY
#define ONLY -1
#endif
#define EN(x) (ONLY < 0 || ONLY == (x))
#ifndef PROBE
#define PROBE 0
#endif
#ifndef MK_MULTI
#define MK_MULTI 0
#endif

#define LAS __attribute__((address_space(3)))
#define DI __device__ __forceinline__
typedef unsigned short bf16_t;
typedef short bf16x8 __attribute__((ext_vector_type(8)));
typedef short s16x4 __attribute__((ext_vector_type(4)));
typedef float f32x4 __attribute__((ext_vector_type(4)));
typedef float f32x16 __attribute__((ext_vector_type(16)));
typedef unsigned u32x4 __attribute__((ext_vector_type(4)));
typedef unsigned u32x2 __attribute__((ext_vector_type(2)));

constexpr int T_ALL = 98304, T_PROMPT = 65536, DM = 1024, DEPTH = 2;
constexpr int NG = 2, TG = T_ALL / NG;
constexpr int NV = 5120;
constexpr int ZW = 4096;
constexpr int B_GATE = 6016;
constexpr int C_RQ = 0, C_RK = 512, C_RV = 1024, C_RG = 1536, C_CQ = 2048, C_CKV = 2304, C_KPE = 2432, C_MG = 2496, C_GR = 3008, C_GM = 4032, C_END = 5056;
constexpr int IN_W = 5056;
constexpr int QW = 1792;
constexpr int KQKV = 256;
constexpr float EPS = 1e-6f;
constexpr int LDS_BYTES = 163840;

constexpr size_t al256(size_t x) { return (x + 255) / 256 * 256; }
constexpr size_t SZ_WIN = (size_t)NV * DM * 2, SZ_WQKV = (size_t)QW * KQKV * 2, SZ_WBR = (size_t)1024 * 512 * 2, SZ_WOUT = (size_t)1024 * 1024 * 2;
constexpr size_t WS_WIN = 0;
constexpr size_t WS_WQKV = WS_WIN + 2 * SZ_WIN;
constexpr size_t WS_WBR = WS_WQKV + 2 * SZ_WQKV;
constexpr size_t WS_WOUT = WS_WBR + 4 * SZ_WBR;
constexpr size_t WS_COSR = WS_WOUT + 2 * SZ_WOUT;
constexpr size_t WS_SINR = WS_COSR + 4096 * 64 * 4;
constexpr size_t WS_COSM = WS_SINR + 4096 * 64 * 4;
constexpr size_t WS_SINM = WS_COSM + 4096 * 32 * 4;
constexpr size_t WS_RS = WS_SINM + 4096 * 32 * 4;
constexpr size_t WS_H = al256(WS_RS + (size_t)TG * 8);
constexpr size_t WS_Z = WS_H + (size_t)TG * 2048;
constexpr size_t WS_QKV = WS_Z + (size_t)TG * ZW * 2;
constexpr size_t WS_END = WS_QKV + (size_t)TG * QW * 2;
constexpr size_t WS_CTL = WS_END, CTL_BYTES = 16384;
constexpr size_t WS_XB = WS_CTL + CTL_BYTES;
constexpr size_t WS_SSQ = WS_XB + (size_t)TG * 2048;
constexpr size_t WS_RS1 = WS_SSQ + (size_t)TG * 64;
constexpr size_t WS_TOP = WS_RS1 + (size_t)TG * 4;
static_assert(WS_TOP <= (size_t)1 << 30, "workspace must fit 1 GiB");

struct Params {
    const float* x_prompt; const float* x_sample; const float* norm_g; const float* w_in; const float* ret_gn_g; const float* q_norm_g; const float* kv_norm_g;
    const float* w_uq; const float* w_ukv; const float* w_br_ret; const float* w_br_mla; const float* w_out; const float* final_norm_g;
    float* out; unsigned char* ws; int ph_lo, ph_hi;
};

typedef __bf16 bf16x2_t __attribute__((ext_vector_type(2)));
typedef float f32x2 __attribute__((ext_vector_type(2)));
DI unsigned cvt_pk(float lo, float hi) { f32x2 v = {lo, hi}; bf16x2_t b = __builtin_convertvector(v, bf16x2_t); return __builtin_bit_cast(unsigned, b); }
DI float bf_lo(unsigned w) { return __uint_as_float(w << 16); }
DI float bf_hi(unsigned w) { return __uint_as_float(w & 0xffff0000u); }
template <int X> DI float swz_xor(float v) { return __int_as_float(__builtin_amdgcn_ds_swizzle(__float_as_int(v), (X << 10) | 0x1f)); }
DI float wave_sum(float v) {
    v += swz_xor<1>(v); v += swz_xor<2>(v); v += swz_xor<4>(v); v += swz_xor<8>(v); v += swz_xor<16>(v);
    auto rr = __builtin_amdgcn_permlane32_swap(__float_as_uint(v), __float_as_uint(v), false, false);
    return __uint_as_float(rr[0]) + __uint_as_float(rr[1]);
}
DI float fast_sigmoid(float x) { return __builtin_amdgcn_rcpf(1.f + __builtin_amdgcn_exp2f(-1.4426950408889634f * x)); }
DI float fast_silu(float x) { return x * fast_sigmoid(x); }
DI int tok_pos(int t) { return t < T_PROMPT ? (t & 2047) : (t & 4095); }
#define SBAR() __builtin_amdgcn_sched_barrier(0)
DI int crow(int r, int hi) { return (r & 3) + 8 * (r >> 2) + 4 * hi; }

__device__ __constant__ float LOG2G_F[4] = {-0.04580368961312479f, -0.02272007650008353f, -0.011315313227834146f, -0.005646563141142063f};
__device__ __constant__ float LOG2G_B[4] = {-0.03223685441264423f, -0.01602838797991282f, -0.007991934616642016f, -0.003990433313311714f};

namespace pg8 {
constexpr int BM = 256, BK = 64, HALF = 128, HTB = HALF * BK * 2, STAGE_BYTES = 8 * HTB, NXCD = 8, WGM = 8;
__host__ __device__ __forceinline__ int lds_byte(int r, int c) { const int st = (r >> 4) * 2 + (c >> 5), rr = r & 15, cc = c & 31, ob = rr * 64 + cc * 2; return st * 1024 + (ob ^ (((ob >> 9) & 1) << 5)); }
__host__ __device__ __forceinline__ void stage_rc(int b, int& R, int& C) { const int st = b / 1024, sb = b % 1024, swz = sb ^ (((sb >> 9) & 1) << 5); R = (st >> 1) * 16 + swz / 64; C = (st & 1) * 32 + (swz % 64) / 2; }
__host__ __device__ __forceinline__ int perm32(int rho) { const int n = rho >> 4, i = rho & 15; return 8 * (i >> 2) + 4 * n + (i & 3); }

struct Unit { int pm, pn; };
struct Gemm { const bf16_t* A; const bf16_t* Bt; int lda, K, nM, nN; int jump_at, jump; int pn_split, a_off2; int nt2; };

struct StaticOrder {
    int nM, nN, nwg, G, c;
    __device__ void init(int nM_, int nN_, int G_, int c_) { nM = nM_; nN = nN_; nwg = nM * nN; G = G_; c = c_; }
    __device__ bool next(int i, Unit& u) const {
        const long L = (long)i * G + c; if (L >= nwg) return false;
        int wgid = (int)L; { const int q = nwg / NXCD, r = nwg % NXCD, xcd = wgid % NXCD, off = wgid / NXCD; wgid = (xcd < r ? xcd * (q + 1) : r * (q + 1) + (xcd - r) * q) + off; }
        const int nig = WGM * nN, gid = wgid / nig, fm = gid * WGM, gsz = (nM - fm) < WGM ? (nM - fm) : WGM;
        u.pm = fm + ((wgid % nig) % gsz); u.pn = (wgid % nig) / gsz; return true;
    }
};

template <class Epi>
DI void gemm_phase(LAS unsigned char* lds, const Gemm g, const StaticOrder& S, const Epi& E, const int tid_in) {
    int tid = tid_in; asm volatile("" : "+v"(tid));
    const int wid = __builtin_amdgcn_readfirstlane(tid >> 6), lane = tid & 63, wr = wid >> 2, wc = wid & 3, fr = lane & 15, fq = lane >> 4;
    const int K = g.K, nt = K / BK;
    unsigned voffA, voffB;
    { int R, C; stage_rc(tid * 16, R, C); voffA = (unsigned)(R * g.lda + C) * 2u; voffB = (unsigned)(R * K + C) * 2u; }
    const size_t dA_ = (size_t)64 * g.lda * 2, dB_ = (size_t)64 * K * 2;
    const size_t kstep = (size_t)(BK * 2);
    const size_t hsA = (size_t)HALF * g.lda * 2, hsB = (size_t)HALF * K * 2;
    const size_t tsA = 2 * hsA, tsB = 2 * hsB;
    const unsigned ldsw = (unsigned)wid * 1024u;
    const int aoff = lds_byte(wr * 64 + fr, fq * 8), boff = lds_byte(wc * 32 + fr, fq * 8);
#define PG8_SA(b, h) (((b) * 2 + (h)) * HTB)
#define PG8_SB(b, h) ((4 + (b) * 2 + (h)) * HTB)
#define PG8_STAGE(bufoff, gbase, voff) do { _Pragma("unroll") for (int _i = 0; _i < 2; ++_i) \
        __builtin_amdgcn_global_load_lds((const unsigned*)((const char*)(gbase) + _i * (sizeof(voff) == 4 && &(voff) == &voffA ? dA_ : dB_) + (voff)), (LAS unsigned*)(lds + (bufoff) + ldsw + _i * 8192), 16, 0, 0); } while (0)
#define PG8_LDA(dst, b, h) do { _Pragma("unroll") for (int m = 0; m < 4; ++m) _Pragma("unroll") for (int k = 0; k < 2; ++k) dst[m][k] = *(const LAS bf16x8*)(lds + PG8_SA(b, h) + aoff + m * 2048 + k * 1024); } while (0)
#define PG8_LDB(dst, b, h) do { _Pragma("unroll") for (int n = 0; n < 2; ++n) _Pragma("unroll") for (int k = 0; k < 2; ++k) dst[n][k] = *(const LAS bf16x8*)(lds + PG8_SB(b, h) + boff + n * 2048 + k * 1024); } while (0)
#define PG8_MMA(ai, bj, At, Bt) do { __builtin_amdgcn_s_setprio(1); _Pragma("unroll") for (int m = 0; m < 4; ++m) _Pragma("unroll") for (int n = 0; n < 2; ++n) _Pragma("unroll") for (int k = 0; k < 2; ++k) \
        acc[ai][bj][m][n] = __builtin_amdgcn_mfma_f32_16x16x32_bf16(Bt[n][k], At[m][k], acc[ai][bj][m][n], 0, 0, 0); __builtin_amdgcn_s_setprio(0); } while (0)
#define PG8_WAIT_V(n) asm volatile("s_waitcnt vmcnt(" #n ")" ::: "memory")
#define PG8_WAIT_L(n) asm volatile("s_waitcnt lgkmcnt(" #n ")" ::: "memory")
#define PG8_BAR __builtin_amdgcn_s_barrier()
#define PG8_SCHED __builtin_amdgcn_sched_barrier(0)
    Unit cur, nxt; int ui = 0;
    if (!S.next(0, cur)) return;
    f32x4 acc[2][2][4][2];
#pragma unroll
    for (int a = 0; a < 2; ++a)
#pragma unroll
        for (int b = 0; b < 2; ++b)
#pragma unroll
            for (int m = 0; m < 4; ++m)
#pragma unroll
                for (int n = 0; n < 2; ++n) acc[a][b][m][n] = (f32x4){0.f, 0.f, 0.f, 0.f};
    bf16x8 At[4][2], B0[2][2], B1[2][2];
    const char* cA = (const char*)g.A + (size_t)cur.pm * tsA + (cur.pn >= g.pn_split ? g.a_off2 : 0); const char* cB = (const char*)g.Bt + (size_t)cur.pn * tsB;
    PG8_STAGE(PG8_SB(0, 0), cB, voffB); PG8_STAGE(PG8_SB(0, 1), cB + hsB, voffB); PG8_STAGE(PG8_SA(0, 0), cA, voffA); PG8_STAGE(PG8_SA(0, 1), cA + hsA, voffA);
    if (wr == 1) PG8_BAR;
    PG8_WAIT_V(2); PG8_BAR;
    PG8_STAGE(PG8_SB(1, 0), cB + kstep, voffB); PG8_STAGE(PG8_SA(1, 0), cA + kstep, voffA); PG8_STAGE(PG8_SB(1, 1), cB + hsB + kstep, voffB);
    PG8_WAIT_V(6); PG8_BAR;
    for (;;) {
        const bool has_next = S.next(ui + 1, nxt);
        const char* nA = has_next ? (const char*)g.A + (size_t)nxt.pm * tsA + (nxt.pn >= g.pn_split ? g.a_off2 : 0) : cA; const char* nB = has_next ? (const char*)g.Bt + (size_t)nxt.pn * tsB : cB;
        const int ntu = (g.nt2 > 0 && cur.pn >= g.pn_split) ? g.nt2 : nt;
        for (int t = 0; t < ntu; t += 2) {
            const bool last = (t == ntu - 2);
            if constexpr (Epi::HAS_MID) { if (t == g.jump_at) { int n1 = -1; asm volatile("" : "+s"(n1)); const int l2 = (int)__builtin_amdgcn_mbcnt_hi(n1, __builtin_amdgcn_mbcnt_lo(n1, 0)); E.mid(acc, cur, wr, wc, l2 & 15, l2 >> 4); } }
            const char* a1 = cA + (size_t)(t + 1) * kstep + ((t + 1) >= g.jump_at ? g.jump : 0);
            const char* a2 = last ? nA : cA + (size_t)(t + 2) * kstep + ((t + 2) >= g.jump_at ? g.jump : 0); const char* b2 = last ? nB : cB + (size_t)(t + 2) * kstep;
            const char* a3 = a2 + kstep; const char* b3 = b2 + kstep;
            PG8_LDB(B0, 0, 0); PG8_LDB(B1, 0, 1); PG8_SCHED; PG8_LDA(At, 0, 0); PG8_STAGE(PG8_SA(1, 1), a1 + hsA, voffA);
            PG8_WAIT_V(8); PG8_WAIT_L(0); PG8_BAR; PG8_MMA(0, 0, At, B0); PG8_MMA(0, 1, At, B1); PG8_BAR; PG8_SCHED;
            PG8_LDA(At, 0, 1); PG8_STAGE(PG8_SB(0, 0), b2, voffB); PG8_STAGE(PG8_SB(0, 1), b2 + hsB, voffB); PG8_STAGE(PG8_SA(0, 0), a2, voffA);
            PG8_WAIT_V(8); PG8_WAIT_L(0); PG8_BAR; PG8_MMA(1, 0, At, B0); PG8_MMA(1, 1, At, B1); PG8_BAR; PG8_SCHED;
            PG8_LDB(B0, 1, 0); PG8_LDB(B1, 1, 1); PG8_SCHED; PG8_LDA(At, 1, 0); PG8_STAGE(PG8_SA(0, 1), a2 + hsA, voffA);
            PG8_WAIT_V(8); PG8_WAIT_L(0); PG8_BAR; PG8_MMA(0, 0, At, B0); PG8_MMA(0, 1, At, B1); PG8_BAR; PG8_SCHED;
            PG8_LDA(At, 1, 1); PG8_STAGE(PG8_SB(1, 0), b3, voffB); PG8_STAGE(PG8_SB(1, 1), b3 + hsB, voffB); PG8_STAGE(PG8_SA(1, 0), a3, voffA);
            PG8_WAIT_V(8); PG8_WAIT_L(0); PG8_BAR; PG8_MMA(1, 0, At, B0); PG8_MMA(1, 1, At, B1); PG8_BAR; PG8_SCHED;
        }
        if (wr == 0) PG8_BAR;
        { int n1 = -1; asm volatile("" : "+s"(n1)); const int l2 = (int)__builtin_amdgcn_mbcnt_hi(n1, __builtin_amdgcn_mbcnt_lo(n1, 0)); E(acc, cur, wr, wc, l2 & 15, l2 >> 4); }
        if (!has_next) break;
#pragma unroll
        for (int a = 0; a < 2; ++a)
#pragma unroll
            for (int b = 0; b < 2; ++b)
#pragma unroll
                for (int m = 0; m < 4; ++m)
#pragma unroll
                    for (int n = 0; n < 2; ++n) acc[a][b][m][n] = (f32x4){0.f, 0.f, 0.f, 0.f};
        cur = nxt; cA = nA; cB = nB; ++ui;
        if (wr == 1) PG8_BAR;
    }
    PG8_WAIT_V(0);
    PG8_BAR;
#undef PG8_SA
#undef PG8_SB
#undef PG8_STAGE
#undef PG8_LDA
#undef PG8_LDB
#undef PG8_MMA
#undef PG8_WAIT_V
#undef PG8_WAIT_L
#undef PG8_BAR
#undef PG8_SCHED
}
}

typedef f32x4 AccT[2][2][4][2];
DI u32x4 pack8(f32x4 a, f32x4 b) { u32x4 w; w.x = cvt_pk(a[0], a[1]); w.y = cvt_pk(a[2], a[3]); w.z = cvt_pk(b[0], b[1]); w.w = cvt_pk(b[2], b[3]); return w; }
DI u32x2 pack4(f32x4 a) { u32x2 w; w.x = cvt_pk(a[0], a[1]); w.y = cvt_pk(a[2], a[3]); return w; }
DI void unpack8(u32x4 w, f32x4& a, f32x4& b) { a = (f32x4){bf_lo(w.x), bf_hi(w.x), bf_lo(w.y), bf_hi(w.y)}; b = (f32x4){bf_lo(w.z), bf_hi(w.z), bf_lo(w.w), bf_hi(w.w)}; }

DI float row_scale(const float* ssq, int row) {
    if (!ssq) return 1.f;
    const f32x4 a = *(const f32x4*)(ssq + row * 16), b = *(const f32x4*)(ssq + row * 16 + 4), c = *(const f32x4*)(ssq + row * 16 + 8), d = *(const f32x4*)(ssq + row * 16 + 12);
    const float s = (((a[0] + a[1]) + (a[2] + a[3])) + ((b[0] + b[1]) + (b[2] + b[3]))) + (((c[0] + c[1]) + (c[2] + c[3])) + ((d[0] + d[1]) + (d[2] + d[3])));
    return __builtin_amdgcn_rsqf(s * (1.f / DM) + EPS);
}
struct EpiIn {
    static constexpr bool HAS_MID = false;
    bf16_t* Z; const float* cosR; const float* sinR; const float* cosM; const float* sinM; int t0; const float* rs1;
    DI void operator()(const AccT& acc, const pg8::Unit& u, int wr, int wc, int fr, int fq) const {
        float rsv[2][4];
#pragma unroll
        for (int ai = 0; ai < 2; ++ai)
#pragma unroll
            for (int m = 0; m < 4; ++m) rsv[ai][m] = rs1 ? rs1[u.pm * 256 + ai * 128 + wr * 64 + m * 16 + fr] : 1.f;
#pragma unroll
        for (int bj = 0; bj < 2; ++bj) {
            const int cblk = u.pn * 256 + bj * 128 + wc * 32;
            int kind;
            if (cblk < C_RV) kind = 0; else if (cblk < C_RG) kind = 1; else if (cblk < C_CQ) kind = 2; else if (cblk < C_KPE) kind = 1;
            else if (cblk < C_MG) kind = 3; else if (cblk < C_GR) kind = 2; else if (cblk < C_END) kind = 4; else kind = 5;
            if (kind == 5) continue;
            if (kind == 0 || kind == 3) {
                const float sc = (kind == 0 && cblk >= C_RK) ? 0.08838834764831845f : 1.0f;
                const int g4 = kind == 0 ? 4 * (((cblk & 127) >> 3) + fq) : 4 * (((cblk - C_KPE) >> 3) + fq);
                const int obase = kind == 0 ? (cblk & ~127) + g4 : C_KPE + g4, half = kind == 0 ? 64 : 32;
                const float* ct = kind == 0 ? cosR : cosM; const float* st = kind == 0 ? sinR : sinM;
                f32x4 cs[2][4], sn[2][4];
#pragma unroll
                for (int ai = 0; ai < 2; ++ai)
#pragma unroll
                    for (int m = 0; m < 4; ++m) {
                        const int pos = tok_pos(t0 + u.pm * 256 + ai * 128 + wr * 64 + m * 16 + fr);
                        cs[ai][m] = *(const f32x4*)(ct + pos * half + g4); sn[ai][m] = *(const f32x4*)(st + pos * half + g4);
                    }
                asm volatile("" ::: "memory");
#pragma unroll
                for (int ai = 0; ai < 2; ++ai)
#pragma unroll
                    for (int m = 0; m < 4; ++m) {
                        const int row = u.pm * 256 + ai * 128 + wr * 64 + m * 16 + fr;
                        const float rsc = sc * rsv[ai][m];
                        const f32x4 x1 = acc[ai][bj][m][0] * rsc, x2 = acc[ai][bj][m][1] * rsc;
                        bf16_t* zp = Z + (size_t)row * ZW + obase;
                        *(u32x2*)zp = pack4(x1 * cs[ai][m] - x2 * sn[ai][m]); *(u32x2*)(zp + half) = pack4(x1 * sn[ai][m] + x2 * cs[ai][m]);
                    }
            } else {
#pragma unroll
                for (int ai = 0; ai < 2; ++ai)
#pragma unroll
                    for (int m = 0; m < 4; ++m) {
                        const int row = u.pm * 256 + ai * 128 + wr * 64 + m * 16 + fr;
                        const float rsc = rsv[ai][m];
                        f32x4 v0 = acc[ai][bj][m][0] * rsc, v1 = acc[ai][bj][m][1] * rsc;
                        if (kind == 4) {
                            unsigned w0 = 0u, w1 = 0u;
#pragma unroll
                            for (int j = 0; j < 4; ++j) {
                                w0 = __builtin_amdgcn_cvt_pk_u8_f32(fminf(fmaxf(fast_sigmoid(v0[j]) * 255.f + 0.5f, 1.0f), 255.0f), j, w0);
                                w1 = __builtin_amdgcn_cvt_pk_u8_f32(fminf(fmaxf(fast_sigmoid(v1[j]) * 255.f + 0.5f, 1.0f), 255.0f), j, w1); }
                            *(u32x2*)((unsigned char*)(Z + (size_t)row * ZW) + B_GATE + (cblk - C_GR) + 8 * fq) = (u32x2){w0, w1};
                        } else {
                            if (kind == 2) { for (int j = 0; j < 4; ++j) { v0[j] = fast_silu(v0[j]); v1[j] = fast_silu(v1[j]); } }
                            *(u32x4*)(Z + (size_t)row * ZW + cblk + 8 * fq) = pack8(v0, v1);
                        }
                    }
            }
        }
    }
};
DI int colsrc_in(int v) {
    if (v < C_RV) { const int vp = v & 127, g = vp >> 3, n = (vp >> 2) & 1, j = vp & 3; return (v & ~127) + 4 * g + j + 64 * n; }
    if (v >= C_KPE && v < C_MG) { const int vp = v - C_KPE, g = vp >> 3, n = (vp >> 2) & 1, j = vp & 3; return C_KPE + 4 * g + j + 32 * n; }
    return v < IN_W ? v : -1;
}

struct EpiQKV {
    static constexpr bool HAS_MID = false;
    bf16_t* Q; const float* rs; const float* cosM; const float* sinM; int t0;
    DI void operator()(const AccT& acc, const pg8::Unit& u, int wr, int wc, int fr, int fq) const {
        const int cb0 = u.pn * 256 + wc * 32, cb1 = cb0 + 128;
        const int isq0 = cb0 < 768, isq1 = cb1 < 768; const int e0 = cb0 % 192, e1 = cb1 % 192;
        const bool rope0 = isq0 && e0 >= 128, rope1 = isq1 && e1 >= 128;
#pragma unroll
        for (int ai = 0; ai < 2; ++ai)
#pragma unroll
            for (int m = 0; m < 4; ++m) {
                const int row = u.pm * 256 + ai * 128 + wr * 64 + m * 16 + fr; const int pos = tok_pos(t0 + row);
                const float sq = rs[row * 2], skv = rs[row * 2 + 1];
#pragma unroll
                for (int bj = 0; bj < 2; ++bj) {
                    const int cblk = bj ? cb1 : cb0; const int e = bj ? e1 : e0; const bool rope = bj ? rope1 : rope0; const float sc = (bj ? isq1 : isq0) ? sq : skv;
                    if (rope) {
                        const int g4 = 4 * (((e - 128) >> 3) + fq), cb = cblk - (e - 128);
                        const f32x4 c = *(const f32x4*)(cosM + pos * 32 + g4), s = *(const f32x4*)(sinM + pos * 32 + g4);
                        const f32x4 x1 = acc[ai][bj][m][0] * sc, x2 = acc[ai][bj][m][1] * sc;
                        bf16_t* qp = Q + (size_t)row * QW + cb + g4;
                        *(u32x2*)qp = pack4(x1 * c - x2 * s); *(u32x2*)(qp + 32) = pack4(x1 * s + x2 * c);
                    } else {
                        *(u32x4*)(Q + (size_t)row * QW + cblk + 8 * fq) = pack8(acc[ai][bj][m][0] * sc, acc[ai][bj][m][1] * sc);
                    }
                }
                asm volatile("" ::: "memory");
            }
    }
};
DI int colsrc_q(int v) {
    const int e = v % 192;
    if (e >= 128) { const int vp = e - 128, g = vp >> 3, n = (vp >> 2) & 1, j = vp & 3; return (v - vp) + 4 * g + j + 32 * n; }
    return v;
}

struct EpiBr {
    static constexpr bool HAS_MID = true;
    bf16_t* Z;
    static DI void ub4(unsigned w, f32x4& f) { f = (f32x4){(float)(w & 255u), (float)((w >> 8) & 255u), (float)((w >> 16) & 255u), (float)(w >> 24)}; }
    DI void mid(AccT& acc, const pg8::Unit& u, int wr, int wc, int fr, int fq) const {
        u32x2 gr[2][4][2], gm[2][4][2];
#pragma unroll
        for (int ai = 0; ai < 2; ++ai)
#pragma unroll
            for (int m = 0; m < 4; ++m)
#pragma unroll
                for (int bj = 0; bj < 2; ++bj) {
                    const unsigned char* p = (const unsigned char*)(Z + (size_t)(u.pm * 256 + ai * 128 + wr * 64 + m * 16 + fr) * ZW) + B_GATE + u.pn * 256 + bj * 128 + wc * 32 + 8 * fq;
                    gr[ai][m][bj] = *(const u32x2*)p; gm[ai][m][bj] = *(const u32x2*)(p + 1024);
                }
        asm volatile("" ::: "memory");
#pragma unroll
        for (int ai = 0; ai < 2; ++ai)
#pragma unroll
            for (int m = 0; m < 4; ++m)
#pragma unroll
                for (int bj = 0; bj < 2; ++bj) {
                    f32x4 g0, g1, m0, m1; ub4(gr[ai][m][bj].x, g0); ub4(gr[ai][m][bj].y, g1); ub4(gm[ai][m][bj].x, m0); ub4(gm[ai][m][bj].y, m1);
#pragma unroll
                    for (int j = 0; j < 4; ++j) { acc[ai][bj][m][0][j] *= g0[j] * __builtin_amdgcn_rcpf(m0[j]); acc[ai][bj][m][1][j] *= g1[j] * __builtin_amdgcn_rcpf(m1[j]); }
                }
    }
    DI void operator()(const AccT& acc, const pg8::Unit& u, int wr, int wc, int fr, int fq) const {
        u32x2 gm[2][4][2];
#pragma unroll
        for (int ai = 0; ai < 2; ++ai)
#pragma unroll
            for (int m = 0; m < 4; ++m)
#pragma unroll
                for (int bj = 0; bj < 2; ++bj)
                    gm[ai][m][bj] = *(const u32x2*)((const unsigned char*)(Z + (size_t)(u.pm * 256 + ai * 128 + wr * 64 + m * 16 + fr) * ZW) + B_GATE + 1024 + u.pn * 256 + bj * 128 + wc * 32 + 8 * fq);
        asm volatile("" ::: "memory");
#pragma unroll
        for (int ai = 0; ai < 2; ++ai)
#pragma unroll
            for (int m = 0; m < 4; ++m)
#pragma unroll
                for (int bj = 0; bj < 2; ++bj) {
                    f32x4 m0, m1; ub4(gm[ai][m][bj].x, m0); ub4(gm[ai][m][bj].y, m1);
                    *(u32x4*)(Z + (size_t)(u.pm * 256 + ai * 128 + wr * 64 + m * 16 + fr) * ZW + u.pn * 256 + bj * 128 + wc * 32 + 8 * fq) = pack8(m0 * (1.f / 255.f) * acc[ai][bj][m][0], m1 * (1.f / 255.f) * acc[ai][bj][m][1]);
                }
    }
};
struct EpiOut0 {
    static constexpr bool HAS_MID = false;
    const float* xp; const float* xs; bf16_t* XB; float* ssq; int t0;
    DI void operator()(const AccT& acc, const pg8::Unit& u, int wr, int wc, int fr, int fq) const {
#pragma unroll
        for (int ai = 0; ai < 2; ++ai)
#pragma unroll
        for (int mh = 0; mh < 2; ++mh) {
            f32x4 xb[2][2][2];
#pragma unroll
            for (int mm = 0; mm < 2; ++mm) {
                const int t = t0 + u.pm * 256 + ai * 128 + wr * 64 + (2 * mh + mm) * 16 + fr;
                const float* base = t < T_PROMPT ? xp + (size_t)t * DM : xs + (size_t)(t - T_PROMPT) * DM;
#pragma unroll
                for (int bj = 0; bj < 2; ++bj) { const int c0 = u.pn * 256 + bj * 128 + wc * 32 + 8 * fq; xb[mm][bj][0] = *(const f32x4*)(base + c0); xb[mm][bj][1] = *(const f32x4*)(base + c0 + 4); }
            }
            asm volatile("" ::: "memory");
#pragma unroll
            for (int mm = 0; mm < 2; ++mm) {
                const int m = 2 * mh + mm;
                const int row = u.pm * 256 + ai * 128 + wr * 64 + m * 16 + fr;
                float ss = 0.f;
#pragma unroll
                for (int bj = 0; bj < 2; ++bj) {
                    const int c0 = u.pn * 256 + bj * 128 + wc * 32 + 8 * fq;
                    const u32x4 w = pack8(xb[mm][bj][0] + acc[ai][bj][m][0], xb[mm][bj][1] + acc[ai][bj][m][1]);
                    *(u32x4*)(XB + (size_t)row * DM + c0) = w;
                    f32x4 r0, r1; unpack8(w, r0, r1);
                    ss += ((r0[0] * r0[0] + r0[1] * r0[1]) + (r0[2] * r0[2] + r0[3] * r0[3])) + ((r1[0] * r1[0] + r1[1] * r1[1]) + (r1[2] * r1[2] + r1[3] * r1[3]));
                }
                ss += swz_xor<16>(ss);
                { auto rr = __builtin_amdgcn_permlane32_swap(__float_as_uint(ss), __float_as_uint(ss), false, false); ss = __uint_as_float(rr[0]) + __uint_as_float(rr[1]); }
                if (fq == 0) ssq[row * 16 + u.pn * 4 + wc] = ss;
            }
        }
    }
};
struct EpiOut1 {
    static constexpr bool HAS_MID = false;
    bf16_t* XB; float* ssq;
    DI void operator()(const AccT& acc, const pg8::Unit& u, int wr, int wc, int fr, int fq) const {
        u32x4 xb[2][4][2];
#pragma unroll
        for (int ai = 0; ai < 2; ++ai)
#pragma unroll
            for (int m = 0; m < 4; ++m)
#pragma unroll
                for (int bj = 0; bj < 2; ++bj)
                    xb[ai][m][bj] = *(const u32x4*)(XB + (size_t)(u.pm * 256 + ai * 128 + wr * 64 + m * 16 + fr) * DM + u.pn * 256 + bj * 128 + wc * 32 + 8 * fq);
        asm volatile("" ::: "memory");
#pragma unroll
        for (int ai = 0; ai < 2; ++ai)
#pragma unroll
            for (int m = 0; m < 4; ++m) {
                const int row = u.pm * 256 + ai * 128 + wr * 64 + m * 16 + fr;
                float ss = 0.f;
#pragma unroll
                for (int bj = 0; bj < 2; ++bj) {
                    const int c0 = u.pn * 256 + bj * 128 + wc * 32 + 8 * fq;
                    f32x4 b0, b1; unpack8(xb[ai][m][bj], b0, b1);
                    const u32x4 w = pack8(b0 + acc[ai][bj][m][0], b1 + acc[ai][bj][m][1]);
                    *(u32x4*)(XB + (size_t)row * DM + c0) = w;
                    f32x4 r0, r1; unpack8(w, r0, r1);
                    ss += ((r0[0] * r0[0] + r0[1] * r0[1]) + (r0[2] * r0[2] + r0[3] * r0[3])) + ((r1[0] * r1[0] + r1[1] * r1[1]) + (r1[2] * r1[2] + r1[3] * r1[3]));
                }
                ss += swz_xor<16>(ss);
                { auto rr = __builtin_amdgcn_permlane32_swap(__float_as_uint(ss), __float_as_uint(ss), false, false); ss = __uint_as_float(rr[0]) + __uint_as_float(rr[1]); }
                if (fq == 0) ssq[row * 16 + u.pn * 4 + wc] = ss;
            }
    }
};

DI int v_st(int k, int c) { const int kk = (k & ~0xC) | ((k & 4) << 1) | ((k & 8) >> 1); return ((kk >> 3) * 4 + (c >> 5)) * 512 + ((kk & 7) * 32 + (c & 31)) * 2; }
DI int v_rd_base(int lane) { return ((lane & 3) << 3) | (((lane >> 2) & 3) << 6) | (((lane >> 4) & 1) << 5) | (((lane >> 5) & 1) << 8); }
constexpr int v_rd_off(int d0, int ks, int half) { return d0 * 512 + ks * 4096 + half * 2048; }
template <int OFF> DI s16x4 tr_read(int vb) { s16x4 r; asm volatile("ds_read_b64_tr_b16 %0, %1 offset:%2" : "=&v"(r) : "v"(vb), "i"(OFF) : "memory"); return r; }
#define PKF(L, H) (bf16x8){L[0], L[1], L[2], L[3], H[0], H[1], H[2], H[3]}
#define MFMA32(a, b, c) __builtin_amdgcn_mfma_f32_32x32x16_bf16((a), (b), (c), 0, 0, 0)
#define LGKM0() asm volatile("s_waitcnt lgkmcnt(0)" ::: "memory")

DI void retA_unit(LAS unsigned char* lds, const bf16_t* Z, bf16_t* ST, int cl, int head, const int tid) {
    const int wid = __builtin_amdgcn_readfirstlane(tid >> 6), lane = tid & 63, r32 = lane & 31, hi = lane >> 5;
    LAS unsigned char* Kimg = lds; LAS unsigned char* Vf = lds + 32768; LAS unsigned char* Vb = lds + 65536;
    const float lf = LOG2G_F[head], lb = LOG2G_B[head];
    const bf16_t* zr = Z + (size_t)cl * 128 * ZW + head * 128;
#pragma unroll
    for (int i = 0; i < 4; ++i) {
        const int p = tid + 512 * i, row = p >> 4, col = (p & 15) * 8;
        const u32x4 kv = *(const u32x4*)(zr + (size_t)row * ZW + C_RK + col);
        const u32x4 vv = *(const u32x4*)(zr + (size_t)row * ZW + C_RV + col);
        const int off = v_st(row, col);
        *(LAS u32x4*)(Kimg + off) = kv;
        f32x4 a, b; unpack8(vv, a, b);
        const float zf = __builtin_amdgcn_exp2f(lf * (float)(127 - row)), zb = __builtin_amdgcn_exp2f(lb * (float)row);
        *(LAS u32x4*)(Vf + off) = pack8(a * zf, b * zf);
        *(LAS u32x4*)(Vb + off) = pack8(a * zb, b * zb);
    }
    __syncthreads();
    const int ab = wid & 3, b0 = 2 * (wid >> 2);
    const int rb = v_rd_base(lane);
    const int ka = (int)(uintptr_t)Kimg + rb + ab * 512, vfa = (int)(uintptr_t)Vf + rb + b0 * 512, vba = (int)(uintptr_t)Vb + rb + b0 * 512;
    f32x16 aF0 = {}, aF1 = {}, aB0 = {}, aB1 = {};
#define RETA_STEP(KS) do { \
        const s16x4 al = tr_read<v_rd_off(0, KS, 0)>(ka), ah = tr_read<v_rd_off(0, KS, 1)>(ka); \
        const s16x4 f0l = tr_read<v_rd_off(0, KS, 0)>(vfa), f0h = tr_read<v_rd_off(0, KS, 1)>(vfa), f1l = tr_read<v_rd_off(1, KS, 0)>(vfa), f1h = tr_read<v_rd_off(1, KS, 1)>(vfa); \
        const s16x4 g0l = tr_read<v_rd_off(0, KS, 0)>(vba), g0h = tr_read<v_rd_off(0, KS, 1)>(vba), g1l = tr_read<v_rd_off(1, KS, 0)>(vba), g1h = tr_read<v_rd_off(1, KS, 1)>(vba); \
        LGKM0(); SBAR(); \
        const bf16x8 A = PKF(al, ah); \
        aF0 = MFMA32(A, PKF(f0l, f0h), aF0); aF1 = MFMA32(A, PKF(f1l, f1h), aF1); aB0 = MFMA32(A, PKF(g0l, g0h), aB0); aB1 = MFMA32(A, PKF(g1l, g1h), aB1); } while (0)
    RETA_STEP(0); RETA_STEP(1); RETA_STEP(2); RETA_STEP(3); RETA_STEP(4); RETA_STEP(5); RETA_STEP(6); RETA_STEP(7);
#undef RETA_STEP
    bf16_t* sf = ST + ((size_t)(cl * 4 + head) * 2) * 16384; bf16_t* sb = sf + 16384;
#pragma unroll
    for (int r = 0; r < 16; ++r) {
        const int dk = 32 * ab + crow(r, hi); const int o = dk * 128 + 32 * b0 + r32;
        sf[o] = (bf16_t)(cvt_pk(aF0[r], 0.f) & 0xffff); sf[o + 32] = (bf16_t)(cvt_pk(aF1[r], 0.f) & 0xffff);
        sb[o] = (bf16_t)(cvt_pk(aB0[r], 0.f) & 0xffff); sb[o + 32] = (bf16_t)(cvt_pk(aB1[r], 0.f) & 0xffff);
    }
    __syncthreads();
}

DI void seq_chunks(int g, int s, int& c0, int& n) {
    if (g == 0) { c0 = s * 16; n = 16; }
    else if (s < 8) { c0 = s * 16; n = 16; }
    else { c0 = 128 + (s - 8) * 32; n = 32; }
}
constexpr int nseq_of(int g) { return g == 0 ? 24 : 16; }

DI void ret_scan(bf16_t* ST, int g, int gtid, int gthreads) {
    const int total = nseq_of(g) * 4 * 2 * 2048;
    for (int i = gtid; i < total; i += gthreads) {
        const int e8 = i & 2047, dir = (i >> 11) & 1, head = (i >> 12) & 3, s = i >> 14;
        int c0, n; seq_chunks(g, s, c0, n);
        const float dec = __builtin_amdgcn_exp2f(128.f * (dir ? LOG2G_B[head] : LOG2G_F[head]));
        f32x4 s0 = {0.f, 0.f, 0.f, 0.f}, s1 = {0.f, 0.f, 0.f, 0.f};
        bf16_t* base = ST + ((size_t)(c0 * 4 + head) * 2 + dir) * 16384 + e8 * 8;
        for (int cb = 0; cb < n; cb += 16) {
            u32x4 a[16];
#pragma unroll
            for (int k = 0; k < 16; ++k) { const int cc = dir ? (n - 1 - (cb + k)) : (cb + k); a[k] = *(const u32x4*)(base + (size_t)cc * 131072); }
#pragma unroll
            for (int k = 0; k < 16; ++k) { const int cc = dir ? (n - 1 - (cb + k)) : (cb + k);
                f32x4 x, y; unpack8(a[k], x, y);
                *(u32x4*)(base + (size_t)cc * 131072) = pack8(s0, s1);
                s0 = s0 * dec + x; s1 = s1 * dec + y; }
        }
    }
}

#define KSWZ(row, colB) ((row) * 256 + ((colB) ^ (((row) & 7) << 4)))
DI void pk4f(const f32x16& P, int base, bf16x8& out) {
    unsigned a0 = cvt_pk(P[base + 0], P[base + 1]), a1 = cvt_pk(P[base + 2], P[base + 3]);
    unsigned b0 = cvt_pk(P[base + 4], P[base + 5]), b1 = cvt_pk(P[base + 6], P[base + 7]);
    auto r0 = __builtin_amdgcn_permlane32_swap(a0, b0, false, false); auto r1 = __builtin_amdgcn_permlane32_swap(a1, b1, false, false);
    u32x4 w = {r0[0], r1[0], r0[1], r1[1]}; out = *reinterpret_cast<bf16x8*>(&w);
}
template <int D0> DI void tr_mma4(f32x16& od, int vb, bf16x8 a0, bf16x8 a1, bf16x8 a2, bf16x8 a3) {
    const s16x4 l0 = tr_read<v_rd_off(D0, 0, 0)>(vb), h0 = tr_read<v_rd_off(D0, 0, 1)>(vb), l1 = tr_read<v_rd_off(D0, 1, 0)>(vb), h1 = tr_read<v_rd_off(D0, 1, 1)>(vb);
    const s16x4 l2 = tr_read<v_rd_off(D0, 2, 0)>(vb), h2 = tr_read<v_rd_off(D0, 2, 1)>(vb), l3 = tr_read<v_rd_off(D0, 3, 0)>(vb), h3 = tr_read<v_rd_off(D0, 3, 1)>(vb);
    LGKM0(); SBAR();
    od = MFMA32(a0, PKF(l0, h0), od); od = MFMA32(a1, PKF(l1, h1), od); od = MFMA32(a2, PKF(l2, h2), od); od = MFMA32(a3, PKF(l3, h3), od);
}
DI bf16x8 scale8(bf16x8 q, float s) {
    const u32x4 w = *reinterpret_cast<const u32x4*>(&q); f32x4 a, b; unpack8(w, a, b); const u32x4 o = pack8(a * s, b * s); return *reinterpret_cast<const bf16x8*>(&o);
}
DI void retO_unit(LAS unsigned char* lds, bf16_t* Z, const bf16_t* ST, const float* gn_g, int cl, int head, const int tid, const bool store) {
    const int wid = __builtin_amdgcn_readfirstlane(tid >> 6), lane = tid & 63, r32 = lane & 31, hi = lane >> 5;
    LAS unsigned char* Ks = lds; LAS unsigned char* Vi = lds + 32768; LAS unsigned char* Sfi = lds + 65536; LAS unsigned char* Sbi = lds + 98304;
    const float lf = LOG2G_F[head], lb = LOG2G_B[head];
    bf16_t* zr = Z + (size_t)cl * 128 * ZW + head * 128;
    const bf16_t* sf = ST + ((size_t)(cl * 4 + head) * 2) * 16384; const bf16_t* sb = sf + 16384;
#pragma unroll
    for (int i = 0; i < 4; ++i) {
        const int p = tid + 512 * i, row = p >> 4, col = (p & 15) * 8;
        const u32x4 kv = *(const u32x4*)(zr + (size_t)row * ZW + C_RK + col);
        const u32x4 vv = *(const u32x4*)(zr + (size_t)row * ZW + C_RV + col);
        const u32x4 s1 = *(const u32x4*)(sf + row * 128 + col);
        const u32x4 s2 = *(const u32x4*)(sb + row * 128 + col);
        const int off = v_st(row, col);
        *(LAS u32x4*)(Ks + KSWZ(row, col * 2)) = kv;
        *(LAS u32x4*)(Vi + off) = vv; *(LAS u32x4*)(Sfi + off) = s1; *(LAS u32x4*)(Sbi + off) = s2;
    }
    const int wq = wid & 3, wk = wid >> 2;
    const int qi = 32 * wq + r32;
    bf16x8 qr[8];
    const bf16_t* qp = zr + (size_t)qi * ZW + C_RQ + hi * 8;
#pragma unroll
    for (int d0 = 0; d0 < 8; ++d0) qr[d0] = *(const bf16x8*)(qp + d0 * 16);
    bf16x8 qx[4];
#pragma unroll
    for (int s = 0; s < 4; ++s) qx[s] = *(const bf16x8*)(qp + (4 * wk + s) * 16);
    __syncthreads();
    f32x16 p0 = {}, p1 = {};
    {
        LAS const unsigned char* Kb = Ks + (64 * wk) * 256;
#pragma unroll
        for (int d0 = 0; d0 < 8; ++d0) { const int cb = (d0 * 16 + hi * 8) * 2;
            const bf16x8 b0 = *(const LAS bf16x8*)(Kb + KSWZ(r32, cb)); const bf16x8 b1 = *(const LAS bf16x8*)(Kb + KSWZ(32 + r32, cb));
            p0 = MFMA32(b0, qr[d0], p0); p1 = MFMA32(b1, qr[d0], p1); }
    }
#pragma unroll
    for (int r = 0; r < 16; ++r) {
        const int j0 = 64 * wk + crow(r, hi), j1 = j0 + 32;
        const float d0 = (float)(qi - j0), d1 = (float)(qi - j1);
        p0[r] *= __builtin_amdgcn_exp2f(d0 >= 0.f ? lf * d0 : -lb * d0);
        p1[r] *= __builtin_amdgcn_exp2f(d1 >= 0.f ? lf * d1 : -lb * d1);
    }
    bf16x8 pa0, pa1, pa2, pa3; pk4f(p0, 0, pa0); pk4f(p0, 8, pa1); pk4f(p1, 0, pa2); pk4f(p1, 8, pa3);
    f32x16 o[4] = {};
    const int rb = v_rd_base(lane) + wk * (4 * 4096);
    const int va = (int)(uintptr_t)Vi + rb, sfa = (int)(uintptr_t)Sfi + rb, sba = (int)(uintptr_t)Sbi + rb;
    tr_mma4<0>(o[0], va, pa0, pa1, pa2, pa3); tr_mma4<1>(o[1], va, pa0, pa1, pa2, pa3); tr_mma4<2>(o[2], va, pa0, pa1, pa2, pa3); tr_mma4<3>(o[3], va, pa0, pa1, pa2, pa3);
    {
        const float xf = __builtin_amdgcn_exp2f(lf * (float)(qi + 1));
        const bf16x8 a0 = scale8(qx[0], xf), a1 = scale8(qx[1], xf), a2 = scale8(qx[2], xf), a3 = scale8(qx[3], xf);
        tr_mma4<0>(o[0], sfa, a0, a1, a2, a3); tr_mma4<1>(o[1], sfa, a0, a1, a2, a3); tr_mma4<2>(o[2], sfa, a0, a1, a2, a3); tr_mma4<3>(o[3], sfa, a0, a1, a2, a3);
    }
    {
        const float xb = __builtin_amdgcn_exp2f(lb * (float)(128 - qi));
        const bf16x8 a0 = scale8(qx[0], xb), a1 = scale8(qx[1], xb), a2 = scale8(qx[2], xb), a3 = scale8(qx[3], xb);
        tr_mma4<0>(o[0], sba, a0, a1, a2, a3); tr_mma4<1>(o[1], sba, a0, a1, a2, a3); tr_mma4<2>(o[2], sba, a0, a1, a2, a3); tr_mma4<3>(o[3], sba, a0, a1, a2, a3);
    }
    __syncthreads();
    const int nrow = tid >> 2, nqd = tid & 3;
    bf16_t* gp = zr + (size_t)nrow * ZW + C_RG + nqd * 32; const float* gg = gn_g + head * 128 + nqd * 32;
    u32x4 gv[4]; f32x4 gw[8];
#pragma unroll
    for (int i = 0; i < 4; ++i) { gv[i] = *(const u32x4*)(gp + i * 8); gw[2 * i] = *(const f32x4*)(gg + i * 8); gw[2 * i + 1] = *(const f32x4*)(gg + i * 8 + 4); }
    LAS float* Ob = (LAS float*)lds;
    if (wk == 1) {
#pragma unroll
        for (int d0 = 0; d0 < 4; ++d0)
#pragma unroll
            for (int r = 0; r < 16; ++r) Ob[(32 * wq + crow(r, hi)) * 132 + 32 * d0 + r32] = o[d0][r];
    }
    __syncthreads();
    if (wk == 0) {
#pragma unroll
        for (int d0 = 0; d0 < 4; ++d0)
#pragma unroll
            for (int r = 0; r < 16; ++r) { LAS float* p = Ob + (32 * wq + crow(r, hi)) * 132 + 32 * d0 + r32; *p = *p + o[d0][r]; }
    }
    __syncthreads();
    {
        const int row = nrow, qd = nqd;
        f32x4 v[8]; float s = 0.f;
#pragma unroll
        for (int i = 0; i < 8; ++i) { v[i] = *(LAS f32x4*)(Ob + row * 132 + qd * 32 + i * 4); s += (v[i][0] + v[i][1]) + (v[i][2] + v[i][3]); }
        s += swz_xor<1>(s); s += swz_xor<2>(s);
        const float mu = s * (1.f / 128.f); float q = 0.f;
#pragma unroll
        for (int i = 0; i < 8; ++i) { v[i] = v[i] - mu; q += (v[i][0] * v[i][0] + v[i][1] * v[i][1]) + (v[i][2] * v[i][2] + v[i][3] * v[i][3]); }
        q += swz_xor<1>(q); q += swz_xor<2>(q);
        const float rstd = __builtin_amdgcn_rsqf(q * (1.f / 128.f) + EPS);
#pragma unroll
        for (int i = 0; i < 4; ++i) {
            f32x4 ga, gb; unpack8(gv[i], ga, gb);
            if (store || rstd == 1.2345e-33f) *(u32x4*)(gp + i * 8) = pack8(v[2 * i] * rstd * gw[2 * i] * ga, v[2 * i + 1] * rstd * gw[2 * i + 1] * gb);
        }
    }
    __syncthreads();
}

namespace att {
constexpr int NW = 8, QBLK = 32, KVBLK = 64;
constexpr float SCALE = 0.07216878364870322f;
constexpr float THR = 8.f;
constexpr int SHM_V = KVBLK * 128 * 2, SHM_KN = KVBLK * 128 * 2, SHM_KP = KVBLK * 64 * 2;
constexpr int OFF_V = 0, OFF_KN = 2 * SHM_V, OFF_KP = OFF_KN + 2 * SHM_KN, OFF_WS = OFF_KP + 2 * SHM_KP, OFF_QP = OFF_WS + 2048;
#define PSWZ(row, colB) ((row) * 128 + ((colB) ^ ((((row) >> 1) & 7) << 4)))
DI void partialSM(f32x16& p0, f32x16& p1, float& m_reg, float& mn, float& alpha) {
    constexpr float C = SCALE * 1.4426950408889634f;
    float pmax = p0[0];
#pragma unroll
    for (int r = 1; r < 16; ++r) pmax = fmaxf(pmax, p0[r]);
#pragma unroll
    for (int r = 0; r < 16; ++r) pmax = fmaxf(pmax, p1[r]);
    { auto rr = __builtin_amdgcn_permlane32_swap(__float_as_uint(pmax), __float_as_uint(pmax), false, false);
      pmax = fmaxf(__uint_as_float(rr[0]), __uint_as_float(rr[1])); }
    if (__builtin_expect(__all(pmax - m_reg <= THR / SCALE), 1)) { mn = m_reg; alpha = 1.f; }
    else { mn = fmaxf(m_reg, pmax); alpha = __builtin_amdgcn_exp2f((m_reg - mn) * C); m_reg = mn; }
    const float mnC = -mn * C;
#pragma unroll
    for (int r = 0; r < 16; ++r) p0[r] = fmaf(p0[r], C, mnC);
#pragma unroll
    for (int r = 0; r < 16; ++r) p1[r] = fmaf(p1[r], C, mnC);
#pragma unroll
    for (int r = 0; r < 16; ++r) p0[r] = __builtin_amdgcn_exp2f(p0[r]);
}
DI void finishSM(f32x16& p0, f32x16& p1, float alpha, float& l_reg, bf16x8& pa0, bf16x8& pa1, bf16x8& pa2, bf16x8& pa3) {
#pragma unroll
    for (int r = 0; r < 16; ++r) p1[r] = __builtin_amdgcn_exp2f(p1[r]);
    float ps = 0;
#pragma unroll
    for (int r = 0; r < 16; ++r) ps += p0[r];
#pragma unroll
    for (int r = 0; r < 16; ++r) ps += p1[r];
    { auto rr = __builtin_amdgcn_permlane32_swap(__float_as_uint(ps), __float_as_uint(ps), false, false);
      ps = __uint_as_float(rr[0]) + __uint_as_float(rr[1]); }
    l_reg = l_reg * alpha + ps;
    pk4f(p0, 0, pa0); pk4f(p0, 8, pa1); pk4f(p1, 0, pa2); pk4f(p1, 8, pa3);
}
#define KFRAG(HALF, D0) ((D0) < 8 ? *(const LAS bf16x8*)(Kn + KSWZ((HALF) * 32 + r32, (((D0) & 7) * 16 + hi * 8) * 2)) : *(const LAS bf16x8*)(Kp + PSWZ((HALF) * 32 + r32, ((((D0) - 8) & 3) * 16 + hi * 8) * 2)))
DI void qkt(f32x16& p0, f32x16& p1, LAS const unsigned char* Kn, LAS const unsigned char* Kp, const bf16x8* qr, LAS const unsigned char* qpl, int r32, int hi) {
    p0 = f32x16{}; p1 = f32x16{};
    bf16x8 fa0 = KFRAG(0, 0), fa1 = KFRAG(1, 0), fb0 = KFRAG(0, 1), fb1 = KFRAG(1, 1);
#pragma unroll
    for (int d0 = 0; d0 < 12; ++d0) {
        bf16x8 fc0 = fa0, fc1 = fa1;
        if (d0 + 2 < 12) { fc0 = KFRAG(0, d0 + 2); fc1 = KFRAG(1, d0 + 2); }
        SBAR();
        p0 = MFMA32(fa0, qr[d0], p0); p1 = MFMA32(fa1, qr[d0], p1);
        SBAR();
        fa0 = fb0; fa1 = fb1; fb0 = fc0; fb1 = fc1;
    }
}
DI void pv_d0(f32x16* o, int vb, bf16x8 pa0, bf16x8 pa1, bf16x8 pa2, bf16x8 pa3) {
    tr_mma4<0>(o[0], vb, pa0, pa1, pa2, pa3); tr_mma4<1>(o[1], vb, pa0, pa1, pa2, pa3); tr_mma4<2>(o[2], vb, pa0, pa1, pa2, pa3); tr_mma4<3>(o[3], vb, pa0, pa1, pa2, pa3);
}
DI void attn_unit(const bf16_t* __restrict__ Qb, const bf16_t* __restrict__ Knh, const bf16_t* __restrict__ Vh, const bf16_t* __restrict__ Kph, bf16_t* Og, int seq, LAS unsigned char* lds, const int tid, const int wid, const bool store) {
    const int  lane = tid & 63, r32 = lane & 31, hi = lane >> 5;
    LAS unsigned char* V_lds = lds + OFF_V; LAS unsigned char* Kn_lds = lds + OFF_KN; LAS unsigned char* Kp_lds = lds + OFF_KP;
    LAS float* ws = (LAS float*)(lds + OFF_WS) + wid * 64; LAS float* li_l = ws; LAS float* al_l = ws + 32;
    float m_reg = -1e30f, l_reg = 0; f32x16 o[4] = {}; bf16x8 qr[12];
    LAS unsigned char* qpl = lds + OFF_QP + wid * 8192 + lane * 16;
    const bf16_t* Qw = Qb + (long)(wid * QBLK + r32) * QW + hi * 8;
#pragma unroll
    for (int d0 = 0; d0 < 12; ++d0) qr[d0] = *(const bf16x8*)(Qw + d0 * 16);
    const int sr = tid >> 4, sc = (tid & 15) * 8, vst0 = v_st(sr, sc), vst1 = v_st(32 + sr, sc);
    const int pr = tid >> 3, pc = (tid & 7) * 8;
    const int vb0 = (int)(uintptr_t)V_lds + v_rd_base(lane);
    bf16x8 vs0, vs1, ks0, ks1, kp0;
    const unsigned voff = (unsigned)(sr * QW + sc), poff = (unsigned)(pr * ZW + pc);
#define SLOAD(k0) do { const bf16_t* kb0_ = Knh + (size_t)(k0) * QW; const bf16_t* kb1_ = kb0_ + 32 * QW; const bf16_t* kpb_ = Kph + (size_t)(k0) * ZW; \
    ks0 = *(const bf16x8*)(kb0_ + voff); ks1 = *(const bf16x8*)(kb1_ + voff); vs0 = *(const bf16x8*)(kb0_ + 128 + voff); vs1 = *(const bf16x8*)(kb1_ + 128 + voff); \
    kp0 = *(const bf16x8*)(kpb_ + poff); } while (0)
#define SWRITE(b) do { *(LAS bf16x8*)(V_lds + (b) * SHM_V + vst0) = vs0; *(LAS bf16x8*)(V_lds + (b) * SHM_V + vst1) = vs1; const int kc = sc * 2; \
    *(LAS bf16x8*)(Kn_lds + (b) * SHM_KN + KSWZ(sr, kc)) = ks0; *(LAS bf16x8*)(Kn_lds + (b) * SHM_KN + KSWZ(32 + sr, kc)) = ks1; \
    *(LAS bf16x8*)(Kp_lds + (b) * SHM_KP + PSWZ(pr, pc * 2)) = kp0; } while (0)
#define SWAIT() asm volatile("s_waitcnt vmcnt(0)" ::: "memory")
#define RESC(a) do { if (__any((a) < 1.f)) { if (hi == 0) al_l[r32] = (a); LGKM0(); \
    _Pragma("unroll") for (int d = 0; d < 4; ++d) _Pragma("unroll") for (int r = 0; r < 16; ++r) o[d][r] *= al_l[crow(r, hi)]; } } while (0)
    f32x16 pA0, pA1; float mnA, alA; bf16x8 pa0, pa1, pa2, pa3; const int NT = seq / KVBLK;
    SLOAD(0); SWAIT(); SWRITE(0); __syncthreads();
    for (int j = 0; j < NT; ++j) {
        const int buf = j & 1;
        if (j + 1 < NT) SLOAD((j + 1) * KVBLK);
        SBAR();
        qkt(pA0, pA1, Kn_lds + buf * SHM_KN, Kp_lds + buf * SHM_KP, qr, qpl, r32, hi);
        partialSM(pA0, pA1, m_reg, mnA, alA);
        finishSM(pA0, pA1, alA, l_reg, pa0, pa1, pa2, pa3);
        RESC(alA); SBAR();
        pv_d0(o, vb0 + buf * SHM_V, pa0, pa1, pa2, pa3);
        if (j + 1 < NT) { SWAIT(); SWRITE(buf ^ 1); }
        __syncthreads();
    }
    if (hi == 0) li_l[r32] = l_reg; LGKM0();
    float rli[16];
#pragma unroll
    for (int r = 0; r < 16; ++r) rli[r] = __builtin_amdgcn_rcpf(li_l[crow(r, hi)]);
    bf16_t* Ow = Og + (long)(wid * QBLK) * ZW;
    if (store || rli[0] == 1.2345e-33f) {
        bf16_t gt[16][4];
#pragma unroll
        for (int r = 0; r < 16; ++r)
#pragma unroll
            for (int d0 = 0; d0 < 4; ++d0) gt[r][d0] = Ow[(long)crow(r, hi) * ZW + d0 * 32 + r32];
        asm volatile("" ::: "memory");
#pragma unroll
        for (int r = 0; r < 16; ++r)
#pragma unroll
            for (int d0 = 0; d0 < 4; ++d0) { const float gate = __uint_as_float((unsigned)gt[r][d0] << 16);
                Ow[(long)crow(r, hi) * ZW + d0 * 32 + r32] = (bf16_t)(cvt_pk(o[d0][r] * rli[r] * gate, 0.f) & 0xffff); }
    }
    __syncthreads();
#undef SLOAD
#undef SWRITE
#undef SWAIT
#undef RESC
}
}

DI void prep_all(const Params& p, unsigned char* ws, int gtid, int gthreads) {
    for (int i = gtid; i < 4096 * 64; i += gthreads) {
        const int pos = i >> 6, f = i & 63;
        const float inv = exp2f(-(float)(2 * f) * (1.f / 128.f) * 13.287712379549449f);
        const double ang = (double)((float)pos * inv) * 0.15915494309189535;
        const float fr = (float)(ang - rint(ang));
        ((float*)(ws + WS_COSR))[i] = __builtin_amdgcn_cosf(fr); ((float*)(ws + WS_SINR))[i] = __builtin_amdgcn_sinf(fr);
    }
    for (int i = gtid; i < 4096 * 32; i += gthreads) {
        const int pos = i >> 5, f = i & 31;
        const float inv = exp2f(-(float)(2 * f) * (1.f / 64.f) * 13.287712379549449f);
        const double ang = (double)((float)pos * inv) * 0.15915494309189535;
        const float fr = (float)(ang - rint(ang));
        ((float*)(ws + WS_COSM))[i] = __builtin_amdgcn_cosf(fr); ((float*)(ws + WS_SINM))[i] = __builtin_amdgcn_sinf(fr);
    }
    for (int l = 0; l < DEPTH; ++l) {
        {
            const float* W = p.w_in + (size_t)l * DM * IN_W; bf16_t* Bt = (bf16_t*)(ws + WS_WIN + l * SZ_WIN);
            for (int i = gtid; i < NV * (DM / 8); i += gthreads) {
                const int R = i % NV, k0 = (i / NV) * 8; const int v = (R & ~31) + pg8::perm32(R & 31); const int src = colsrc_in(v);
                float x[8];
#pragma unroll
                for (int j = 0; j < 8; ++j) x[j] = src >= 0 ? W[(size_t)(k0 + j) * IN_W + src] * (l == 1 ? p.norm_g[DM + k0 + j] : 1.f) : 0.f;
                u32x4 o; o.x = cvt_pk(x[0], x[1]); o.y = cvt_pk(x[2], x[3]); o.z = cvt_pk(x[4], x[5]); o.w = cvt_pk(x[6], x[7]);
                *(u32x4*)(Bt + (size_t)R * DM + k0) = o;
            }
        }
        {
            const float* Wq = p.w_uq + (size_t)l * 256 * 768; const float* Wkv = p.w_ukv + (size_t)l * 128 * 1024;
            const float* gq = p.q_norm_g + l * 256; const float* gkv = p.kv_norm_g + l * 128; bf16_t* Bt = (bf16_t*)(ws + WS_WQKV + l * SZ_WQKV);
            for (int i = gtid; i < QW * (KQKV / 8); i += gthreads) {
                const int R = i % QW, k0 = (i / QW) * 8; const int v = (R & ~31) + pg8::perm32(R & 31);
                float x[8];
#pragma unroll
                for (int j = 0; j < 8; ++j) { const int k = k0 + j;
                    if (v < 768) x[j] = Wq[(size_t)k * 768 + colsrc_q(v)] * gq[k];
                    else x[j] = k < 128 ? Wkv[(size_t)k * 1024 + (v - 768)] * gkv[k] : 0.f; }
                u32x4 o; o.x = cvt_pk(x[0], x[1]); o.y = cvt_pk(x[2], x[3]); o.z = cvt_pk(x[4], x[5]); o.w = cvt_pk(x[6], x[7]);
                *(u32x4*)(Bt + (size_t)R * KQKV + k0) = o;
            }
        }
        for (int which = 0; which < 2; ++which) {
            bf16_t* Bt = which == 1 ? (bf16_t*)(ws + WS_WOUT + l * SZ_WOUT) : (bf16_t*)(ws + WS_WBR + l * 2 * SZ_WBR);
            for (int i = gtid; i < 1024 * (1024 / 8); i += gthreads) {
                const int R = i % 1024, k0 = (i / 1024) * 8; const int v = (R & ~31) + pg8::perm32(R & 31);
                const float* W = which == 1 ? p.w_out + (size_t)l * 1024 * 1024 + (size_t)k0 * 1024
                               : (k0 < 512 ? p.w_br_ret + (size_t)l * 512 * 1024 + (size_t)k0 * 1024 : p.w_br_mla + (size_t)l * 512 * 1024 + (size_t)(k0 - 512) * 1024);
                float x[8];
#pragma unroll
                for (int j = 0; j < 8; ++j) x[j] = W[(size_t)j * 1024 + v];
                u32x4 o; o.x = cvt_pk(x[0], x[1]); o.y = cvt_pk(x[2], x[3]); o.z = cvt_pk(x[4], x[5]); o.w = cvt_pk(x[6], x[7]);
                *(u32x4*)(Bt + (size_t)R * 1024 + k0) = o;
            }
        }
    }
}

#define XB_TMO      128
#define XB_XCNT(j)  (256  + 64 * (j))
#define XB_XSUB(j)  (1280 + 64 * (j))
#define XB_XGEN(j)  (2304 + 64 * (j))
#define XB_TOP      3328
#define XB_TOPGEN   3392
#define XCD_BAR_WORDS 3456
#define XB_SPIN_CAP (1u << 18)

__device__ __forceinline__ unsigned xb_ld(unsigned* p)              { return __hip_atomic_load(p, __ATOMIC_RELAXED, __HIP_MEMORY_SCOPE_AGENT); }
__device__ __forceinline__ unsigned xb_add(unsigned* p, unsigned v) { return __hip_atomic_fetch_add(p, v, __ATOMIC_RELAXED, __HIP_MEMORY_SCOPE_AGENT); }
__device__ __forceinline__ unsigned xb_xcc_id() { return (unsigned)__builtin_amdgcn_s_getreg((3 << 11) | 20) & 0xFu; }
#define XB_SPIN(cond, bar) do { unsigned _sp = 0; while (cond) { __builtin_amdgcn_s_sleep(1); \
    if ((++_sp & 255u) == 0u) { if (xb_ld(&(bar)[XB_TMO])) break; if (_sp > XB_SPIN_CAP) { atomicAdd(&(bar)[XB_TMO], 1u); break; } } } } while (0)

struct XcdBarrier {
    unsigned* bar; unsigned x;
    volatile LAS unsigned* st;
};

__device__ __forceinline__ XcdBarrier xcd_barrier_post(unsigned* bar, volatile LAS unsigned* st) {
    XcdBarrier b; b.bar = bar; b.x = xb_xcc_id(); b.st = st;
    if (threadIdx.x == 0) (void)xb_add(&bar[XB_XCNT(b.x)], 1u);
    return b;
}
__device__ __forceinline__ void xcd_barrier_complete(unsigned* bar, unsigned x, unsigned& nloc, unsigned& nx) {
    const unsigned G = gridDim.x * gridDim.y * gridDim.z;
    unsigned sum, cnt, mine, sp = 0u;
    for (;;) {
        sum = 0u; cnt = 0u; mine = 0u;
#pragma unroll
        for (unsigned j = 0; j < 16; ++j) { const unsigned c = xb_ld(&bar[XB_XCNT(j)]); sum += c; cnt += (c > 0u) ? 1u : 0u; mine = (j == x) ? c : mine; }
        if (sum == G) break;
        __builtin_amdgcn_s_sleep(1);
        if ((++sp & 255u) == 0u) { if (xb_ld(&bar[XB_TMO])) break; if (sp > XB_SPIN_CAP) { atomicAdd(&bar[XB_TMO], 1u); break; } }
    }
    nloc = mine > 0u ? mine : 1u; nx = cnt > 0u ? cnt : 1u;
}

__device__ __forceinline__ void xcd_barrier(const XcdBarrier& b, const bool t0) {
    asm volatile("s_waitcnt vmcnt(0)" ::: "memory");
    __syncthreads();
    if (t0) {
        unsigned* bar = b.bar;
        __builtin_amdgcn_s_waitcnt(0);
        unsigned nloc = b.st[0], nx = b.st[1];
        if (nloc == 0u) { xcd_barrier_complete(bar, b.x, nloc, nx); b.st[0] = nloc; b.st[1] = nx; }
        const unsigned old = xb_add(&bar[XB_XSUB(b.x)], 1u);
        const unsigned gen = old / nloc;
        if (old + 1u == (gen + 1u) * nloc) {
            __builtin_amdgcn_fence(__ATOMIC_RELEASE, "agent");
            asm volatile("s_waitcnt vmcnt(0)" ::: "memory");
            const unsigned og = xb_add(&bar[XB_TOP], 1u);
            const unsigned tg = og / nx;
            if (og + 1u == (tg + 1u) * nx) xb_add(&bar[XB_TOPGEN], 1u);
            else XB_SPIN(xb_ld(&bar[XB_TOPGEN]) == tg, bar);
            __builtin_amdgcn_fence(__ATOMIC_ACQUIRE, "agent");
            xb_add(&bar[XB_XGEN(b.x)], 1u);
            asm volatile("s_waitcnt vmcnt(0)" ::: "memory");
        } else {
            XB_SPIN(xb_ld(&bar[XB_XGEN(b.x)]) == gen, bar);
            __builtin_amdgcn_fence(__ATOMIC_ACQUIRE, "agent");
            asm volatile("s_waitcnt vmcnt(0)" ::: "memory");
        }
    }
    __syncthreads();
}

#define FINAL_NORM(TLO, THI) do { const float* gfin = p.final_norm_g; \
    const f32x4 g0 = *(const f32x4*)(gfin + 8 * lane), g1 = *(const f32x4*)(gfin + 8 * lane + 4), g2 = *(const f32x4*)(gfin + 512 + 8 * lane), g3 = *(const f32x4*)(gfin + 512 + 8 * lane + 4); \
    for (int r0 = gw; r0 < TG; r0 += 8 * NGW) { u32x4 w0[8], w1[8]; float rsx[8]; \
        _Pragma("unroll") for (int k = 0; k < 8; ++k) { const int r = (r0 + k * NGW) < TG ? (r0 + k * NGW) : r0; \
            w0[k] = *(const u32x4*)(XB + (size_t)r * DM + 8 * lane); w1[k] = *(const u32x4*)(XB + (size_t)r * DM + 512 + 8 * lane); rsx[k] = row_scale(SSQ, r); } \
        asm volatile("" ::: "memory"); \
        _Pragma("unroll") for (int k = 0; k < 8; ++k) { const int r = r0 + k * NGW; if (r < TG) { float* yr = p.out + (size_t)((TLO) + r) * DM; const float rs = rsx[k]; \
            f32x4 a0, a1, b0, b1; unpack8(w0[k], a0, a1); unpack8(w1[k], b0, b1); \
            *(f32x4*)(yr + 8 * lane) = a0 * rs * g0; *(f32x4*)(yr + 8 * lane + 4) = a1 * rs * g1; *(f32x4*)(yr + 512 + 8 * lane) = b0 * rs * g2; *(f32x4*)(yr + 512 + 8 * lane + 4) = b1 * rs * g3; } } } } while (0)
constexpr int PH_PER = 7, N_PHASES = 1 + DEPTH * NG * PH_PER + 1;

__global__ void __launch_bounds__(512) mega_fwd(Params p) {
    extern __shared__ __attribute__((aligned(16))) unsigned char lds_raw[];
    LAS unsigned char* lds = (LAS unsigned char*)lds_raw;
    cg::grid_group grid = cg::this_grid();
    volatile LAS unsigned* bst = (volatile LAS unsigned*)(lds + LDS_BYTES - 16);
    if (threadIdx.x < 4) bst[threadIdx.x] = 0u;
    __syncthreads();
    (void)xcd_barrier_post((unsigned*)(p.ws + WS_CTL), bst);
    int wave_s = __builtin_amdgcn_readfirstlane(threadIdx.x >> 6); asm volatile("" : "+s"(wave_s));
    for (int ph = p.ph_lo; ph < p.ph_hi; ++ph) {
    int neg1 = -1; asm volatile("" : "+s"(neg1));
    int tid = wave_s * 64 + (int)__builtin_amdgcn_mbcnt_hi(neg1, __builtin_amdgcn_mbcnt_lo(neg1, 0)); asm volatile("" : "+v"(tid));
    size_t zoff = 0; asm volatile("" : "+s"(zoff));
    unsigned char* ws = p.ws + zoff;
    int G = gridDim.x, bx = blockIdx.x; asm volatile("" : "+s"(G), "+s"(bx));
    const int vcu = (G % 8 == 0) ? (bx % 8) * (G / 8) + bx / 8 : bx;
#define lane (tid & 63)
#define gtid (bx * 512 + tid)
#define gthreads (G * 512)
#define gw (vcu * 8 + wave_s)
#define NGW (G * 8)
    bf16_t* H = (bf16_t*)(ws + WS_H); bf16_t* ST = H; bf16_t* Z = (bf16_t*)(ws + WS_Z); bf16_t* QKV = (bf16_t*)(ws + WS_QKV); float* RS = (float*)(ws + WS_RS);
    bf16_t* XB = (bf16_t*)(ws + WS_XB); float* SSQ = (float*)(ws + WS_SSQ); float* RS1 = (float*)(ws + WS_RS1);
    const float* cosR = (const float*)(ws + WS_COSR); const float* sinR = (const float*)(ws + WS_SINR);
    const float* cosM = (const float*)(ws + WS_COSM); const float* sinM = (const float*)(ws + WS_SINM);
        if (ph == 0) {
            if (EN(100)) prep_all(p, ws, gtid, gthreads);
            if (PROBE == 8) prep_all(p, ws, gtid, gthreads);
        } else if (ph == N_PHASES - 1 && EN(101)) {
            FINAL_NORM(T_ALL - TG, T_ALL);
        } else {
            const int q = ph - 1, g = q / (DEPTH * PH_PER), l = (q / PH_PER) % DEPTH, sub = q % PH_PER;
            const int t0 = g * TG;
            if (sub == 0 && l == 1) {
                for (int r = gtid; r < TG; r += gthreads) RS1[r] = row_scale(SSQ, r);
            } else
            if (sub == 0 && EN(0)) {
                const float* gn = p.norm_g + l * DM;
                f32x4 gg[4];
#pragma unroll
                for (int j = 0; j < 4; ++j) gg[j] = *(const f32x4*)(gn + 256 * j + 4 * lane);
                for (int r0 = gw; r0 < TG; r0 += 4 * NGW) {
                    f32x4 v[4][4];
#pragma unroll
                    for (int k = 0; k < 4; ++k) { const int r = r0 + k * NGW; const int t = t0 + (r < TG ? r : r0);
                        const float* xr = t < T_PROMPT ? p.x_prompt + (size_t)t * DM : p.x_sample + (size_t)(t - T_PROMPT) * DM;
#pragma unroll
                        for (int j = 0; j < 4; ++j) v[k][j] = *(const f32x4*)(xr + 256 * j + 4 * lane); }
                    asm volatile("" ::: "memory");
#pragma unroll
                    for (int k = 0; k < 4; ++k) { const int r = r0 + k * NGW; float s = 0.f;
#pragma unroll
                        for (int j = 0; j < 4; ++j) s += (v[k][j][0] * v[k][j][0] + v[k][j][1] * v[k][j][1]) + (v[k][j][2] * v[k][j][2] + v[k][j][3] * v[k][j][3]);
                        const float rs = __builtin_amdgcn_rsqf(wave_sum(s) * (1.f / DM) + EPS);
                        if (r < TG) {
#pragma unroll
                            for (int j = 0; j < 4; ++j) *(u32x2*)(H + (size_t)r * DM + 256 * j + 4 * lane) = pack4(v[k][j] * rs * gg[j]); } }
                }
                if (g == 1 && l == 0) FINAL_NORM(0, TG);
            } else if (sub == 1 && EN(1)) {
                pg8::Gemm gm{l == 0 ? H : XB, (const bf16_t*)(ws + WS_WIN + l * SZ_WIN), DM, DM, TG / 256, NV / 256, 1 << 20, 0, 1 << 20, 0, 0};
                pg8::StaticOrder S; S.init(gm.nM, gm.nN, G, bx);
                EpiIn E{Z, cosR, sinR, cosM, sinM, t0, l == 0 ? (const float*)nullptr : (const float*)RS1};
                pg8::gemm_phase<EpiIn>(lds, gm, S, E, tid);
                if (PROBE == 1) pg8::gemm_phase<EpiIn>(lds, gm, S, E, tid);
            } else if (sub == 2 && EN(2)) {
                for (int r0 = gw; r0 < TG; r0 += 8 * NGW) {
                    u32x2 a[8]; unsigned b[8];
#pragma unroll
                    for (int k = 0; k < 8; ++k) { const int r = r0 + k * NGW; const bf16_t* zr = Z + (size_t)(r < TG ? r : r0) * ZW;
                        a[k] = *(const u32x2*)(zr + C_CQ + 4 * lane); b[k] = *(const unsigned*)(zr + C_CKV + 2 * lane); }
                    asm volatile("" ::: "memory");
#pragma unroll
                    for (int k = 0; k < 8; ++k) { const int r = r0 + k * NGW;
                        float s1 = bf_lo(a[k].x) * bf_lo(a[k].x) + bf_hi(a[k].x) * bf_hi(a[k].x) + bf_lo(a[k].y) * bf_lo(a[k].y) + bf_hi(a[k].y) * bf_hi(a[k].y);
                        float s2 = bf_lo(b[k]) * bf_lo(b[k]) + bf_hi(b[k]) * bf_hi(b[k]);
                        s1 = wave_sum(s1); s2 = wave_sum(s2);
                        if (lane == 0 && r < TG) { RS[r * 2] = __builtin_amdgcn_rsqf(s1 * (1.f / 256.f) + EPS); RS[r * 2 + 1] = __builtin_amdgcn_rsqf(s2 * (1.f / 128.f) + EPS); } }
                }
                __syncthreads();
                for (int rep = (PROBE == 4 ? 0 : 1); rep < 2; ++rep)
                for (int u = vcu; u < (TG / 128) * 4; u += G) retA_unit(lds, Z, ST, u >> 2, u & 3, tid);
            } else if (sub == 3 && EN(3)) {
#define DO_QKV() do { pg8::Gemm gm{Z + C_CQ, (const bf16_t*)(ws + WS_WQKV + l * SZ_WQKV), ZW, KQKV, TG / 256, QW / 256, 1 << 20, 0, 3, (C_CKV - C_CQ) * 2, 2}; \
                    pg8::StaticOrder S; S.init(gm.nM, gm.nN, G, bx); EpiQKV E{QKV, RS, cosM, sinM, t0}; pg8::gemm_phase<EpiQKV>(lds, gm, S, E, tid); } while (0)
                if (vcu & 1) { ret_scan(ST, g, gtid, gthreads); asm volatile("" : "+v"(tid)); DO_QKV(); }
                else { DO_QKV(); asm volatile("" : "+v"(tid)); ret_scan(ST, g, gtid, gthreads); }
            } else if (sub == 4 && (EN(4) || EN(8))) {
#define DO_RETO() do { const float* gng = p.ret_gn_g + l * 512; for (int u = vcu; u < (TG / 128) * 4; u += G) retO_unit(lds, Z, ST, gng, u >> 2, u & 3, tid, true); } while (0)
#define DO_ATTN() do { const int n_prompt_units = (g == 0 ? 24 : 8) * 32, n_units = n_prompt_units + (g == 0 ? 0 : 8 * 64); \
                    for (int u = vcu; u < n_units; u += G) { int row0, seqlen, head, qb; \
                        if (u < n_prompt_units) { const int s = u >> 5, rem = u & 31; head = rem >> 3; qb = rem & 7; row0 = s * 2048; seqlen = 2048; } \
                        else { const int uu = u - n_prompt_units; const int s = uu >> 6, rem = uu & 63; head = rem >> 4; qb = rem & 15; row0 = (T_PROMPT - t0) + s * 4096; seqlen = 4096; } \
                        const bf16_t* kv = QKV + (size_t)row0 * QW + 768 + head * 256; \
                        att::attn_unit(QKV + (size_t)(row0 + qb * 256) * QW + head * 192, kv, kv + 128, Z + (size_t)row0 * ZW + C_KPE, \
                                       Z + (size_t)(row0 + qb * 256) * ZW + C_MG + head * 128, seqlen, lds, tid, wave_s, true); } } while (0)
                if (vcu & 1) { DO_ATTN(); asm volatile("" : "+v"(tid)); DO_RETO(); }
                else { DO_RETO(); asm volatile("" : "+v"(tid)); DO_ATTN(); }
            } else if (sub == 5 && EN(5)) {
                pg8::Gemm gm{Z + C_RG, (const bf16_t*)(ws + WS_WBR + l * 2 * SZ_WBR), ZW, 1024, TG / 256, 4, 8, (C_MG - C_RG - 512) * 2, 1 << 20, 0, 0};
                pg8::StaticOrder S; S.init(gm.nM, gm.nN, G, bx);
                EpiBr E{Z};
                pg8::gemm_phase<EpiBr>(lds, gm, S, E, tid);
            } else if (sub == 6 && EN(7)) {
                pg8::Gemm gm{Z, (const bf16_t*)(ws + WS_WOUT + l * SZ_WOUT), ZW, 1024, TG / 256, 4, 1 << 20, 0, 1 << 20, 0, 0};
                pg8::StaticOrder S; S.init(gm.nM, gm.nN, G, bx);
                if (l == 0) { EpiOut0 E{p.x_prompt, p.x_sample, XB, SSQ, t0}; pg8::gemm_phase<EpiOut0>(lds, gm, S, E, tid); }
                else { EpiOut1 E{XB, SSQ}; pg8::gemm_phase<EpiOut1>(lds, gm, S, E, tid); }
            }
        }
        if (ph + 1 < p.ph_hi) { if (p.ph_hi < 0) grid.sync(); else { XcdBarrier xb2; xb2.bar = (unsigned*)(p.ws + WS_CTL); xb2.x = xb_xcc_id(); xb2.st = (volatile LAS unsigned*)(lds + LDS_BYTES - 16); int n1b = -1; asm volatile("" : "+s"(n1b)); xcd_barrier(xb2, wave_s == 0 && __builtin_amdgcn_mbcnt_hi(n1b, __builtin_amdgcn_mbcnt_lo(n1b, 0)) == 0); } }
    }
}

extern "C" void kernel_launch(void* const* d_in, const int* in_sizes, int n_in, void* d_out, int out_size, void* d_ws, size_t ws_size, hipStream_t stream) {
    static int grid_blocks = 0;
    if (!grid_blocks) {
        int dev = 0, cus = 0, per_cu = 0;
        hipGetDevice(&dev);
        hipDeviceGetAttribute(&cus, hipDeviceAttributeMultiprocessorCount, dev);
        hipFuncSetAttribute((const void*)mega_fwd, hipFuncAttributeMaxDynamicSharedMemorySize, LDS_BYTES);
        hipOccupancyMaxActiveBlocksPerMultiprocessor(&per_cu, (const void*)mega_fwd, 512, LDS_BYTES);
        if (per_cu < 1) { fprintf(stderr, "kernel_launch: occupancy query says %d blocks/CU\n", per_cu); per_cu = 1; }
        grid_blocks = cus * per_cu;
        if (ws_size < WS_END) fprintf(stderr, "kernel_launch: workspace too small: %zu < %zu\n", ws_size, (size_t)WS_END);
    }
    Params p{};
    p.x_prompt = (const float*)d_in[0]; p.x_sample = (const float*)d_in[1]; p.norm_g = (const float*)d_in[2]; p.w_in = (const float*)d_in[3];
    p.ret_gn_g = (const float*)d_in[4]; p.q_norm_g = (const float*)d_in[5]; p.kv_norm_g = (const float*)d_in[6]; p.w_uq = (const float*)d_in[7];
    p.w_ukv = (const float*)d_in[8]; p.w_br_ret = (const float*)d_in[9]; p.w_br_mla = (const float*)d_in[10]; p.w_out = (const float*)d_in[11];
    p.final_norm_g = (const float*)d_in[12]; p.out = (float*)d_out; p.ws = (unsigned char*)d_ws;
#if MK_MULTI
    for (int ph = 0; ph < N_PHASES; ++ph) {
        p.ph_lo = ph; p.ph_hi = ph + 1;
        hipLaunchKernelGGL(mega_fwd, dim3(grid_blocks), dim3(512), LDS_BYTES, stream, p);
    }
#else
    p.ph_lo = 0; p.ph_hi = N_PHASES;
    if (hipMemsetAsync((char*)d_ws + WS_CTL, 0, CTL_BYTES, stream) != hipSuccess) fprintf(stderr, "memset failed\n");
    void* args[] = {&p};
    hipError_t e = hipLaunchCooperativeKernel((const void*)mega_fwd, dim3(grid_blocks), dim3(512), args, LDS_BYTES, stream);
    if (e != hipSuccess) fprintf(stderr, "cooperative launch failed: %s (grid %d)\n", hipGetErrorString(e), grid_blocks);
#endif
}
```

```cpp
#include <hip/hip_runtime.h>
#include <hip/hip_cooperative_groups.h>
#include <cstdio>
#include <cstdint>
namespace cg = cooperative_groups;

#ifndef ONLY
#define ONLY -1
#endif
#define EN(x) (ONLY < 0 || ONLY == (x))
#ifndef PROBE
#define PROBE 0
#endif
#ifndef MK_MULTI
#define MK_MULTI 0
#endif

#define LAS __attribute__((address_space(3)))
#define DI __device__ __forceinline__
typedef unsigned short bf16_t;
typedef short bf16x8 __attribute__((ext_vector_type(8)));
typedef short s16x4 __attribute__((ext_vector_type(4)));
typedef float f32x4 __attribute__((ext_vector_type(4)));
typedef float f32x16 __attribute__((ext_vector_type(16)));
typedef unsigned u32x4 __attribute__((ext_vector_type(4)));
typedef unsigned u32x2 __attribute__((ext_vector_type(2)));

constexpr int T_ALL = 98304, T_PROMPT = 65536, DM = 1024, DEPTH = 2;
constexpr int NG = 2, TG = T_ALL / NG;
constexpr int NV = 5120;
constexpr int ZW = 4096;
constexpr int B_GATE = 6016;
constexpr int C_RQ = 0, C_RK = 512, C_RV = 1024, C_RG = 1536, C_CQ = 2048, C_CKV = 2304, C_KPE = 2432, C_MG = 2496, C_GR = 3008, C_GM = 4032, C_END = 5056;
constexpr int IN_W = 5056;
constexpr int QW = 1792;
constexpr int KQKV = 256;
constexpr float EPS = 1e-6f;
constexpr int LDS_BYTES = 163840;

constexpr size_t al256(size_t x) { return (x + 255) / 256 * 256; }
constexpr size_t SZ_WIN = (size_t)NV * DM * 2, SZ_WQKV = (size_t)QW * KQKV * 2, SZ_WBR = (size_t)1024 * 512 * 2, SZ_WOUT = (size_t)1024 * 1024 * 2;
constexpr size_t WS_WIN = 0;
constexpr size_t WS_WQKV = WS_WIN + 2 * SZ_WIN;
constexpr size_t WS_WBR = WS_WQKV + 2 * SZ_WQKV;
constexpr size_t WS_WOUT = WS_WBR + 4 * SZ_WBR;
constexpr size_t WS_COSR = WS_WOUT + 2 * SZ_WOUT;
constexpr size_t WS_SINR = WS_COSR + 4096 * 64 * 4;
constexpr size_t WS_COSM = WS_SINR + 4096 * 64 * 4;
constexpr size_t WS_SINM = WS_COSM + 4096 * 32 * 4;
constexpr size_t WS_RS = WS_SINM + 4096 * 32 * 4;
constexpr size_t WS_H = al256(WS_RS + (size_t)TG * 8);
constexpr size_t WS_Z = WS_H + (size_t)TG * 2048;
constexpr size_t WS_QKV = WS_Z + (size_t)TG * ZW * 2;
constexpr size_t WS_END = WS_QKV + (size_t)TG * QW * 2;
constexpr size_t WS_CTL = WS_END, CTL_BYTES = 16384;
constexpr size_t WS_XB = WS_CTL + CTL_BYTES;
constexpr size_t WS_SSQ = WS_XB + (size_t)TG * 2048;
constexpr size_t WS_RS1 = WS_SSQ + (size_t)TG * 64;
constexpr size_t WS_TOP = WS_RS1 + (size_t)TG * 4;
static_assert(WS_TOP <= (size_t)1 << 30, "workspace must fit 1 GiB");

struct Params {
    const float* x_prompt; const float* x_sample; const float* norm_g; const float* w_in; const float* ret_gn_g; const float* q_norm_g; const float* kv_norm_g;
    const float* w_uq; const float* w_ukv; const float* w_br_ret; const float* w_br_mla; const float* w_out; const float* final_norm_g;
    float* out; unsigned char* ws; int ph_lo, ph_hi;
};

typedef __bf16 bf16x2_t __attribute__((ext_vector_type(2)));
typedef float f32x2 __attribute__((ext_vector_type(2)));
DI unsigned cvt_pk(float lo, float hi) { f32x2 v = {lo, hi}; bf16x2_t b = __builtin_convertvector(v, bf16x2_t); return __builtin_bit_cast(unsigned, b); }
DI float bf_lo(unsigned w) { return __uint_as_float(w << 16); }
DI float bf_hi(unsigned w) { return __uint_as_float(w & 0xffff0000u); }
template <int X> DI float swz_xor(float v) { return __int_as_float(__builtin_amdgcn_ds_swizzle(__float_as_int(v), (X << 10) | 0x1f)); }
DI float wave_sum(float v) {
    v += swz_xor<1>(v); v += swz_xor<2>(v); v += swz_xor<4>(v); v += swz_xor<8>(v); v += swz_xor<16>(v);
    auto rr = __builtin_amdgcn_permlane32_swap(__float_as_uint(v), __float_as_uint(v), false, false);
    return __uint_as_float(rr[0]) + __uint_as_float(rr[1]);
}
DI float fast_sigmoid(float x) { return __builtin_amdgcn_rcpf(1.f + __builtin_amdgcn_exp2f(-1.4426950408889634f * x)); }
DI float fast_silu(float x) { return x * fast_sigmoid(x); }
DI int tok_pos(int t) { return t < T_PROMPT ? (t & 2047) : (t & 4095); }
#define SBAR() __builtin_amdgcn_sched_barrier(0)
DI int crow(int r, int hi) { return (r & 3) + 8 * (r >> 2) + 4 * hi; }

__device__ __constant__ float LOG2G_F[4] = {-0.04580368961312479f, -0.02272007650008353f, -0.011315313227834146f, -0.005646563141142063f};
__device__ __constant__ float LOG2G_B[4] = {-0.03223685441264423f, -0.01602838797991282f, -0.007991934616642016f, -0.003990433313311714f};

namespace pg8 {
constexpr int BM = 256, BK = 64, HALF = 128, HTB = HALF * BK * 2, STAGE_BYTES = 8 * HTB, NXCD = 8, WGM = 8;
__host__ __device__ __forceinline__ int lds_byte(int r, int c) { const int st = (r >> 4) * 2 + (c >> 5), rr = r & 15, cc = c & 31, ob = rr * 64 + cc * 2; return st * 1024 + (ob ^ (((ob >> 9) & 1) << 5)); }
__host__ __device__ __forceinline__ void stage_rc(int b, int& R, int& C) { const int st = b / 1024, sb = b % 1024, swz = sb ^ (((sb >> 9) & 1) << 5); R = (st >> 1) * 16 + swz / 64; C = (st & 1) * 32 + (swz % 64) / 2; }
__host__ __device__ __forceinline__ int perm32(int rho) { const int n = rho >> 4, i = rho & 15; return 8 * (i >> 2) + 4 * n + (i & 3); }

struct Unit { int pm, pn; };
struct Gemm { const bf16_t* A; const bf16_t* Bt; int lda, K, nM, nN; int jump_at, jump; int pn_split, a_off2; int nt2; };

struct StaticOrder {
    int nM, nN, nwg, G, c;
    __device__ void init(int nM_, int nN_, int G_, int c_) { nM = nM_; nN = nN_; nwg = nM * nN; G = G_; c = c_; }
    __device__ bool next(int i, Unit& u) const {
        const long L = (long)i * G + c; if (L >= nwg) return false;
        int wgid = (int)L; { const int q = nwg / NXCD, r = nwg % NXCD, xcd = wgid % NXCD, off = wgid / NXCD; wgid = (xcd < r ? xcd * (q + 1) : r * (q + 1) + (xcd - r) * q) + off; }
        const int nig = WGM * nN, gid = wgid / nig, fm = gid * WGM, gsz = (nM - fm) < WGM ? (nM - fm) : WGM;
        u.pm = fm + ((wgid % nig) % gsz); u.pn = (wgid % nig) / gsz; return true;
    }
};

template <class Epi>
DI void gemm_phase(LAS unsigned char* lds, const Gemm g, const StaticOrder& S, const Epi& E, const int tid_in) {
    int tid = tid_in; asm volatile("" : "+v"(tid));
    const int wid = __builtin_amdgcn_readfirstlane(tid >> 6), lane = tid & 63, wr = wid >> 2, wc = wid & 3, fr = lane & 15, fq = lane >> 4;
    const int K = g.K, nt = K / BK;
    unsigned voffA, voffB;
    { int R, C; stage_rc(tid * 16, R, C); voffA = (unsigned)(R * g.lda + C) * 2u; voffB = (unsigned)(R * K + C) * 2u; }
    const size_t dA_ = (size_t)64 * g.lda * 2, dB_ = (size_t)64 * K * 2;
    const size_t kstep = (size_t)(BK * 2);
    const size_t hsA = (size_t)HALF * g.lda * 2, hsB = (size_t)HALF * K * 2;
    const size_t tsA = 2 * hsA, tsB = 2 * hsB;
    const unsigned ldsw = (unsigned)wid * 1024u;
    const int aoff = lds_byte(wr * 64 + fr, fq * 8), boff = lds_byte(wc * 32 + fr, fq * 8);
#define PG8_SA(b, h) (((b) * 2 + (h)) * HTB)
#define PG8_SB(b, h) ((4 + (b) * 2 + (h)) * HTB)
#define PG8_STAGE(bufoff, gbase, voff) do { _Pragma("unroll") for (int _i = 0; _i < 2; ++_i) \
        __builtin_amdgcn_global_load_lds((const unsigned*)((const char*)(gbase) + _i * (sizeof(voff) == 4 && &(voff) == &voffA ? dA_ : dB_) + (voff)), (LAS unsigned*)(lds + (bufoff) + ldsw + _i * 8192), 16, 0, 0); } while (0)
#define PG8_LDA(dst, b, h) do { _Pragma("unroll") for (int m = 0; m < 4; ++m) _Pragma("unroll") for (int k = 0; k < 2; ++k) dst[m][k] = *(const LAS bf16x8*)(lds + PG8_SA(b, h) + aoff + m * 2048 + k * 1024); } while (0)
#define PG8_LDB(dst, b, h) do { _Pragma("unroll") for (int n = 0; n < 2; ++n) _Pragma("unroll") for (int k = 0; k < 2; ++k) dst[n][k] = *(const LAS bf16x8*)(lds + PG8_SB(b, h) + boff + n * 2048 + k * 1024); } while (0)
#define PG8_MMA(ai, bj, At, Bt) do { __builtin_amdgcn_s_setprio(1); _Pragma("unroll") for (int m = 0; m < 4; ++m) _Pragma("unroll") for (int n = 0; n < 2; ++n) _Pragma("unroll") for (int k = 0; k < 2; ++k) \
        acc[ai][bj][m][n] = __builtin_amdgcn_mfma_f32_16x16x32_bf16(Bt[n][k], At[m][k], acc[ai][bj][m][n], 0, 0, 0); __builtin_amdgcn_s_setprio(0); } while (0)
#define PG8_WAIT_V(n) asm volatile("s_waitcnt vmcnt(" #n ")" ::: "memory")
#define PG8_WAIT_L(n) asm volatile("s_waitcnt lgkmcnt(" #n ")" ::: "memory")
#define PG8_BAR __builtin_amdgcn_s_barrier()
#define PG8_SCHED __builtin_amdgcn_sched_barrier(0)
    Unit cur, nxt; int ui = 0;
    if (!S.next(0, cur)) return;
    f32x4 acc[2][2][4][2];
#pragma unroll
    for (int a = 0; a < 2; ++a)
#pragma unroll
        for (int b = 0; b < 2; ++b)
#pragma unroll
            for (int m = 0; m < 4; ++m)
#pragma unroll
                for (int n = 0; n < 2; ++n) acc[a][b][m][n] = (f32x4){0.f, 0.f, 0.f, 0.f};
    bf16x8 At[4][2], B0[2][2], B1[2][2];
    const char* cA = (const char*)g.A + (size_t)cur.pm * tsA + (cur.pn >= g.pn_split ? g.a_off2 : 0); const char* cB = (const char*)g.Bt + (size_t)cur.pn * tsB;
    PG8_STAGE(PG8_SB(0, 0), cB, voffB); PG8_STAGE(PG8_SB(0, 1), cB + hsB, voffB); PG8_STAGE(PG8_SA(0, 0), cA, voffA); PG8_STAGE(PG8_SA(0, 1), cA + hsA, voffA);
    if (wr == 1) PG8_BAR;
    PG8_WAIT_V(2); PG8_BAR;
    PG8_STAGE(PG8_SB(1, 0), cB + kstep, voffB); PG8_STAGE(PG8_SA(1, 0), cA + kstep, voffA); PG8_STAGE(PG8_SB(1, 1), cB + hsB + kstep, voffB);
    PG8_WAIT_V(6); PG8_BAR;
    for (;;) {
        const bool has_next = S.next(ui + 1, nxt);
        const char* nA = has_next ? (const char*)g.A + (size_t)nxt.pm * tsA + (nxt.pn >= g.pn_split ? g.a_off2 : 0) : cA; const char* nB = has_next ? (const char*)g.Bt + (size_t)nxt.pn * tsB : cB;
        const int ntu = (g.nt2 > 0 && cur.pn >= g.pn_split) ? g.nt2 : nt;
        for (int t = 0; t < ntu; t += 2) {
            const bool last = (t == ntu - 2);
            if constexpr (Epi::HAS_MID) { if (t == g.jump_at) { int n1 = -1; asm volatile("" : "+s"(n1)); const int l2 = (int)__builtin_amdgcn_mbcnt_hi(n1, __builtin_amdgcn_mbcnt_lo(n1, 0)); E.mid(acc, cur, wr, wc, l2 & 15, l2 >> 4); } }
            const char* a1 = cA + (size_t)(t + 1) * kstep + ((t + 1) >= g.jump_at ? g.jump : 0);
            const char* a2 = last ? nA : cA + (size_t)(t + 2) * kstep + ((t + 2) >= g.jump_at ? g.jump : 0); const char* b2 = last ? nB : cB + (size_t)(t + 2) * kstep;
            const char* a3 = a2 + kstep; const char* b3 = b2 + kstep;
            PG8_LDB(B0, 0, 0); PG8_LDB(B1, 0, 1); PG8_SCHED; PG8_LDA(At, 0, 0); PG8_STAGE(PG8_SA(1, 1), a1 + hsA, voffA);
            PG8_WAIT_V(8); PG8_WAIT_L(0); PG8_BAR; PG8_MMA(0, 0, At, B0); PG8_MMA(0, 1, At, B1); PG8_BAR; PG8_SCHED;
            PG8_LDA(At, 0, 1); PG8_STAGE(PG8_SB(0, 0), b2, voffB); PG8_STAGE(PG8_SB(0, 1), b2 + hsB, voffB); PG8_STAGE(PG8_SA(0, 0), a2, voffA);
            PG8_WAIT_V(8); PG8_WAIT_L(0); PG8_BAR; PG8_MMA(1, 0, At, B0); PG8_MMA(1, 1, At, B1); PG8_BAR; PG8_SCHED;
            PG8_LDB(B0, 1, 0); PG8_LDB(B1, 1, 1); PG8_SCHED; PG8_LDA(At, 1, 0); PG8_STAGE(PG8_SA(0, 1), a2 + hsA, voffA);
            PG8_WAIT_V(8); PG8_WAIT_L(0); PG8_BAR; PG8_MMA(0, 0, At, B0); PG8_MMA(0, 1, At, B1); PG8_BAR; PG8_SCHED;
            PG8_LDA(At, 1, 1); PG8_STAGE(PG8_SB(1, 0), b3, voffB); PG8_STAGE(PG8_SB(1, 1), b3 + hsB, voffB); PG8_STAGE(PG8_SA(1, 0), a3, voffA);
            PG8_WAIT_V(8); PG8_WAIT_L(0); PG8_BAR; PG8_MMA(1, 0, At, B0); PG8_MMA(1, 1, At, B1); PG8_BAR; PG8_SCHED;
        }
        if (wr == 0) PG8_BAR;
        { int n1 = -1; asm volatile("" : "+s"(n1)); const int l2 = (int)__builtin_amdgcn_mbcnt_hi(n1, __builtin_amdgcn_mbcnt_lo(n1, 0)); E(acc, cur, wr, wc, l2 & 15, l2 >> 4); }
        if (!has_next) break;
#pragma unroll
        for (int a = 0; a < 2; ++a)
#pragma unroll
            for (int b = 0; b < 2; ++b)
#pragma unroll
                for (int m = 0; m < 4; ++m)
#pragma unroll
                    for (int n = 0; n < 2; ++n) acc[a][b][m][n] = (f32x4){0.f, 0.f, 0.f, 0.f};
        cur = nxt; cA = nA; cB = nB; ++ui;
        if (wr == 1) PG8_BAR;
    }
    PG8_WAIT_V(0);
    PG8_BAR;
#undef PG8_SA
#undef PG8_SB
#undef PG8_STAGE
#undef PG8_LDA
#undef PG8_LDB
#undef PG8_MMA
#undef PG8_WAIT_V
#undef PG8_WAIT_L
#undef PG8_BAR
#undef PG8_SCHED
}
}

typedef f32x4 AccT[2][2][4][2];
DI u32x4 pack8(f32x4 a, f32x4 b) { u32x4 w; w.x = cvt_pk(a[0], a[1]); w.y = cvt_pk(a[2], a[3]); w.z = cvt_pk(b[0], b[1]); w.w = cvt_pk(b[2], b[3]); return w; }
DI u32x2 pack4(f32x4 a) { u32x2 w; w.x = cvt_pk(a[0], a[1]); w.y = cvt_pk(a[2], a[3]); return w; }
DI void unpack8(u32x4 w, f32x4& a, f32x4& b) { a = (f32x4){bf_lo(w.x), bf_hi(w.x), bf_lo(w.y), bf_hi(w.y)}; b = (f32x4){bf_lo(w.z), bf_hi(w.z), bf_lo(w.w), bf_hi(w.w)}; }

DI float row_scale(const float* ssq, int row) {
    if (!ssq) return 1.f;
    const f32x4 a = *(const f32x4*)(ssq + row * 16), b = *(const f32x4*)(ssq + row * 16 + 4), c = *(const f32x4*)(ssq + row * 16 + 8), d = *(const f32x4*)(ssq + row * 16 + 12);
    const float s = (((a[0] + a[1]) + (a[2] + a[3])) + ((b[0] + b[1]) + (b[2] + b[3]))) + (((c[0] + c[1]) + (c[2] + c[3])) + ((d[0] + d[1]) + (d[2] + d[3])));
    return __builtin_amdgcn_rsqf(s * (1.f / DM) + EPS);
}
struct EpiIn {
    static constexpr bool HAS_MID = false;
    bf16_t* Z; const float* cosR; const float* sinR; const float* cosM; const float* sinM; int t0; const float* rs1;
    DI void operator()(const AccT& acc, const pg8::Unit& u, int wr, int wc, int fr, int fq) const {
        float rsv[2][4];
#pragma unroll
        for (int ai = 0; ai < 2; ++ai)
#pragma unroll
            for (int m = 0; m < 4; ++m) rsv[ai][m] = rs1 ? rs1[u.pm * 256 + ai * 128 + wr * 64 + m * 16 + fr] : 1.f;
#pragma unroll
        for (int bj = 0; bj < 2; ++bj) {
            const int cblk = u.pn * 256 + bj * 128 + wc * 32;
            int kind;
            if (cblk < C_RV) kind = 0; else if (cblk < C_RG) kind = 1; else if (cblk < C_CQ) kind = 2; else if (cblk < C_KPE) kind = 1;
            else if (cblk < C_MG) kind = 3; else if (cblk < C_GR) kind = 2; else if (cblk < C_END) kind = 4; else kind = 5;
            if (kind == 5) continue;
            if (kind == 0 || kind == 3) {
                const float sc = (kind == 0 && cblk >= C_RK) ? 0.08838834764831845f : 1.0f;
                const int g4 = kind == 0 ? 4 * (((cblk & 127) >> 3) + fq) : 4 * (((cblk - C_KPE) >> 3) + fq);
                const int obase = kind == 0 ? (cblk & ~127) + g4 : C_KPE + g4, half = kind == 0 ? 64 : 32;
                const float* ct = kind == 0 ? cosR : cosM; const float* st = kind == 0 ? sinR : sinM;
                f32x4 cs[2][4], sn[2][4];
#pragma unroll
                for (int ai = 0; ai < 2; ++ai)
#pragma unroll
                    for (int m = 0; m < 4; ++m) {
                        const int pos = tok_pos(t0 + u.pm * 256 + ai * 128 + wr * 64 + m * 16 + fr);
                        cs[ai][m] = *(const f32x4*)(ct + pos * half + g4); sn[ai][m] = *(const f32x4*)(st + pos * half + g4);
                    }
                asm volatile("" ::: "memory");
#pragma unroll
                for (int ai = 0; ai < 2; ++ai)
#pragma unroll
                    for (int m = 0; m < 4; ++m) {
                        const int row = u.pm * 256 + ai * 128 + wr * 64 + m * 16 + fr;
                        const float rsc = sc * rsv[ai][m];
                        const f32x4 x1 = acc[ai][bj][m][0] * rsc, x2 = acc[ai][bj][m][1] * rsc;
                        bf16_t* zp = Z + (size_t)row * ZW + obase;
                        *(u32x2*)zp = pack4(x1 * cs[ai][m] - x2 * sn[ai][m]); *(u32x2*)(zp + half) = pack4(x1 * sn[ai][m] + x2 * cs[ai][m]);
                    }
            } else {
#pragma unroll
                for (int ai = 0; ai < 2; ++ai)
#pragma unroll
                    for (int m = 0; m < 4; ++m) {
                        const int row = u.pm * 256 + ai * 128 + wr * 64 + m * 16 + fr;
                        const float rsc = rsv[ai][m];
                        f32x4 v0 = acc[ai][bj][m][0] * rsc, v1 = acc[ai][bj][m][1] * rsc;
                        if (kind == 4) {
                            unsigned w0 = 0u, w1 = 0u;
#pragma unroll
                            for (int j = 0; j < 4; ++j) {
                                w0 = __builtin_amdgcn_cvt_pk_u8_f32(fminf(fmaxf(fast_sigmoid(v0[j]) * 255.f + 0.5f, 1.0f), 255.0f), j, w0);
                                w1 = __builtin_amdgcn_cvt_pk_u8_f32(fminf(fmaxf(fast_sigmoid(v1[j]) * 255.f + 0.5f, 1.0f), 255.0f), j, w1); }
                            *(u32x2*)((unsigned char*)(Z + (size_t)row * ZW) + B_GATE + (cblk - C_GR) + 8 * fq) = (u32x2){w0, w1};
                        } else {
                            if (kind == 2) { for (int j = 0; j < 4; ++j) { v0[j] = fast_silu(v0[j]); v1[j] = fast_silu(v1[j]); } }
                            *(u32x4*)(Z + (size_t)row * ZW + cblk + 8 * fq) = pack8(v0, v1);
                        }
                    }
            }
        }
    }
};
DI int colsrc_in(int v) {
    if (v < C_RV) { const int vp = v & 127, g = vp >> 3, n = (vp >> 2) & 1, j = vp & 3; return (v & ~127) + 4 * g + j + 64 * n; }
    if (v >= C_KPE && v < C_MG) { const int vp = v - C_KPE, g = vp >> 3, n = (vp >> 2) & 1, j = vp & 3; return C_KPE + 4 * g + j + 32 * n; }
    return v < IN_W ? v : -1;
}

struct EpiQKV {
    static constexpr bool HAS_MID = false;
    bf16_t* Q; const float* rs; const float* cosM; const float* sinM; int t0;
    DI void operator()(const AccT& acc, const pg8::Unit& u, int wr, int wc, int fr, int fq) const {
        const int cb0 = u.pn * 256 + wc * 32, cb1 = cb0 + 128;
        const int isq0 = cb0 < 768, isq1 = cb1 < 768; const int e0 = cb0 % 192, e1 = cb1 % 192;
        const bool rope0 = isq0 && e0 >= 128, rope1 = isq1 && e1 >= 128;
#pragma unroll
        for (int ai = 0; ai < 2; ++ai)
#pragma unroll
            for (int m = 0; m < 4; ++m) {
                const int row = u.pm * 256 + ai * 128 + wr * 64 + m * 16 + fr; const int pos = tok_pos(t0 + row);
                const float sq = rs[row * 2], skv = rs[row * 2 + 1];
#pragma unroll
                for (int bj = 0; bj < 2; ++bj) {
                    const int cblk = bj ? cb1 : cb0; const int e = bj ? e1 : e0; const bool rope = bj ? rope1 : rope0; const float sc = (bj ? isq1 : isq0) ? sq : skv;
                    if (rope) {
                        const int g4 = 4 * (((e - 128) >> 3) + fq), cb = cblk - (e - 128);
                        const f32x4 c = *(const f32x4*)(cosM + pos * 32 + g4), s = *(const f32x4*)(sinM + pos * 32 + g4);
                        const f32x4 x1 = acc[ai][bj][m][0] * sc, x2 = acc[ai][bj][m][1] * sc;
                        bf16_t* qp = Q + (size_t)row * QW + cb + g4;
                        *(u32x2*)qp = pack4(x1 * c - x2 * s); *(u32x2*)(qp + 32) = pack4(x1 * s + x2 * c);
                    } else {
                        *(u32x4*)(Q + (size_t)row * QW + cblk + 8 * fq) = pack8(acc[ai][bj][m][0] * sc, acc[ai][bj][m][1] * sc);
                    }
                }
                asm volatile("" ::: "memory");
            }
    }
};
DI int colsrc_q(int v) {
    const int e = v % 192;
    if (e >= 128) { const int vp = e - 128, g = vp >> 3, n = (vp >> 2) & 1, j = vp & 3; return (v - vp) + 4 * g + j + 32 * n; }
    return v;
}

struct EpiBr {
    static constexpr bool HAS_MID = true;
    bf16_t* Z;
    static DI void ub4(unsigned w, f32x4& f) { f = (f32x4){(float)(w & 255u), (float)((w >> 8) & 255u), (float)((w >> 16) & 255u), (float)(w >> 24)}; }
    DI void mid(AccT& acc, const pg8::Unit& u, int wr, int wc, int fr, int fq) const {
        u32x2 gr[2][4][2], gm[2][4][2];
#pragma unroll
        for (int ai = 0; ai < 2; ++ai)
#pragma unroll
            for (int m = 0; m < 4; ++m)
#pragma unroll
                for (int bj = 0; bj < 2; ++bj) {
                    const unsigned char* p = (const unsigned char*)(Z + (size_t)(u.pm * 256 + ai * 128 + wr * 64 + m * 16 + fr) * ZW) + B_GATE + u.pn * 256 + bj * 128 + wc * 32 + 8 * fq;
                    gr[ai][m][bj] = *(const u32x2*)p; gm[ai][m][bj] = *(const u32x2*)(p + 1024);
                }
        asm volatile("" ::: "memory");
#pragma unroll
        for (int ai = 0; ai < 2; ++ai)
#pragma unroll
            for (int m = 0; m < 4; ++m)
#pragma unroll
                for (int bj = 0; bj < 2; ++bj) {
                    f32x4 g0, g1, m0, m1; ub4(gr[ai][m][bj].x, g0); ub4(gr[ai][m][bj].y, g1); ub4(gm[ai][m][bj].x, m0); ub4(gm[ai][m][bj].y, m1);
#pragma unroll
                    for (int j = 0; j < 4; ++j) { acc[ai][bj][m][0][j] *= g0[j] * __builtin_amdgcn_rcpf(m0[j]); acc[ai][bj][m][1][j] *= g1[j] * __builtin_amdgcn_rcpf(m1[j]); }
                }
    }
    DI void operator()(const AccT& acc, const pg8::Unit& u, int wr, int wc, int fr, int fq) const {
        u32x2 gm[2][4][2];
#pragma unroll
        for (int ai = 0; ai < 2; ++ai)
#pragma unroll
            for (int m = 0; m < 4; ++m)
#pragma unroll
                for (int bj = 0; bj < 2; ++bj)
                    gm[ai][m][bj] = *(const u32x2*)((const unsigned char*)(Z + (size_t)(u.pm * 256 + ai * 128 + wr * 64 + m * 16 + fr) * ZW) + B_GATE + 1024 + u.pn * 256 + bj * 128 + wc * 32 + 8 * fq);
        asm volatile("" ::: "memory");
#pragma unroll
        for (int ai = 0; ai < 2; ++ai)
#pragma unroll
            for (int m = 0; m < 4; ++m)
#pragma unroll
                for (int bj = 0; bj < 2; ++bj) {
                    f32x4 m0, m1; ub4(gm[ai][m][bj].x, m0); ub4(gm[ai][m][bj].y, m1);
                    *(u32x4*)(Z + (size_t)(u.pm * 256 + ai * 128 + wr * 64 + m * 16 + fr) * ZW + u.pn * 256 + bj * 128 + wc * 32 + 8 * fq) = pack8(m0 * (1.f / 255.f) * acc[ai][bj][m][0], m1 * (1.f / 255.f) * acc[ai][bj][m][1]);
                }
    }
};
struct EpiOut0 {
    static constexpr bool HAS_MID = false;
    const float* xp; const float* xs; bf16_t* XB; float* ssq; int t0;
    DI void operator()(const AccT& acc, const pg8::Unit& u, int wr, int wc, int fr, int fq) const {
#pragma unroll
        for (int ai = 0; ai < 2; ++ai)
#pragma unroll
        for (int mh = 0; mh < 2; ++mh) {
            f32x4 xb[2][2][2];
#pragma unroll
            for (int mm = 0; mm < 2; ++mm) {
                const int t = t0 + u.pm * 256 + ai * 128 + wr * 64 + (2 * mh + mm) * 16 + fr;
                const float* base = t < T_PROMPT ? xp + (size_t)t * DM : xs + (size_t)(t - T_PROMPT) * DM;
#pragma unroll
                for (int bj = 0; bj < 2; ++bj) { const int c0 = u.pn * 256 + bj * 128 + wc * 32 + 8 * fq; xb[mm][bj][0] = *(const f32x4*)(base + c0); xb[mm][bj][1] = *(const f32x4*)(base + c0 + 4); }
            }
            asm volatile("" ::: "memory");
#pragma unroll
            for (int mm = 0; mm < 2; ++mm) {
                const int m = 2 * mh + mm;
                const int row = u.pm * 256 + ai * 128 + wr * 64 + m * 16 + fr;
                float ss = 0.f;
#pragma unroll
                for (int bj = 0; bj < 2; ++bj) {
                    const int c0 = u.pn * 256 + bj * 128 + wc * 32 + 8 * fq;
                    const u32x4 w = pack8(xb[mm][bj][0] + acc[ai][bj][m][0], xb[mm][bj][1] + acc[ai][bj][m][1]);
                    *(u32x4*)(XB + (size_t)row * DM + c0) = w;
                    f32x4 r0, r1; unpack8(w, r0, r1);
                    ss += ((r0[0] * r0[0] + r0[1] * r0[1]) + (r0[2] * r0[2] + r0[3] * r0[3])) + ((r1[0] * r1[0] + r1[1] * r1[1]) + (r1[2] * r1[2] + r1[3] * r1[3]));
                }
                ss += swz_xor<16>(ss);
                { auto rr = __builtin_amdgcn_permlane32_swap(__float_as_uint(ss), __float_as_uint(ss), false, false); ss = __uint_as_float(rr[0]) + __uint_as_float(rr[1]); }
                if (fq == 0) ssq[row * 16 + u.pn * 4 + wc] = ss;
            }
        }
    }
};
struct EpiOut1 {
    static constexpr bool HAS_MID = false;
    bf16_t* XB; float* ssq;
    DI void operator()(const AccT& acc, const pg8::Unit& u, int wr, int wc, int fr, int fq) const {
        u32x4 xb[2][4][2];
#pragma unroll
        for (int ai = 0; ai < 2; ++ai)
#pragma unroll
            for (int m = 0; m < 4; ++m)
#pragma unroll
                for (int bj = 0; bj < 2; ++bj)
                    xb[ai][m][bj] = *(const u32x4*)(XB + (size_t)(u.pm * 256 + ai * 128 + wr * 64 + m * 16 + fr) * DM + u.pn * 256 + bj * 128 + wc * 32 + 8 * fq);
        asm volatile("" ::: "memory");
#pragma unroll
        for (int ai = 0; ai < 2; ++ai)
#pragma unroll
            for (int m = 0; m < 4; ++m) {
                const int row = u.pm * 256 + ai * 128 + wr * 64 + m * 16 + fr;
                float ss = 0.f;
#pragma unroll
                for (int bj = 0; bj < 2; ++bj) {
                    const int c0 = u.pn * 256 + bj * 128 + wc * 32 + 8 * fq;
                    f32x4 b0, b1; unpack8(xb[ai][m][bj], b0, b1);
                    const u32x4 w = pack8(b0 + acc[ai][bj][m][0], b1 + acc[ai][bj][m][1]);
                    *(u32x4*)(XB + (size_t)row * DM + c0) = w;
                    f32x4 r0, r1; unpack8(w, r0, r1);
                    ss += ((r0[0] * r0[0] + r0[1] * r0[1]) + (r0[2] * r0[2] + r0[3] * r0[3])) + ((r1[0] * r1[0] + r1[1] * r1[1]) + (r1[2] * r1[2] + r1[3] * r1[3]));
                }
                ss += swz_xor<16>(ss);
                { auto rr = __builtin_amdgcn_permlane32_swap(__float_as_uint(ss), __float_as_uint(ss), false, false); ss = __uint_as_float(rr[0]) + __uint_as_float(rr[1]); }
                if (fq == 0) ssq[row * 16 + u.pn * 4 + wc] = ss;
            }
    }
};

DI int v_st(int k, int c) { const int kk = (k & ~0xC) | ((k & 4) << 1) | ((k & 8) >> 1); return ((kk >> 3) * 4 + (c >> 5)) * 512 + ((kk & 7) * 32 + (c & 31)) * 2; }
DI int v_rd_base(int lane) { return ((lane & 3) << 3) | (((lane >> 2) & 3) << 6) | (((lane >> 4) & 1) << 5) | (((lane >> 5) & 1) << 8); }
constexpr int v_rd_off(int d0, int ks, int half) { return d0 * 512 + ks * 4096 + half * 2048; }
template <int OFF> DI s16x4 tr_read(int vb) { s16x4 r; asm volatile("ds_read_b64_tr_b16 %0, %1 offset:%2" : "=&v"(r) : "v"(vb), "i"(OFF) : "memory"); return r; }
#define PKF(L, H) (bf16x8){L[0], L[1], L[2], L[3], H[0], H[1], H[2], H[3]}
#define MFMA32(a, b, c) __builtin_amdgcn_mfma_f32_32x32x16_bf16((a), (b), (c), 0, 0, 0)
#define LGKM0() asm volatile("s_waitcnt lgkmcnt(0)" ::: "memory")

DI void retA_unit(LAS unsigned char* lds, const bf16_t* Z, bf16_t* ST, int cl, int head, const int tid) {
    const int wid = __builtin_amdgcn_readfirstlane(tid >> 6), lane = tid & 63, r32 = lane & 31, hi = lane >> 5;
    LAS unsigned char* Kimg = lds; LAS unsigned char* Vf = lds + 32768; LAS unsigned char* Vb = lds + 65536;
    const float lf = LOG2G_F[head], lb = LOG2G_B[head];
    const bf16_t* zr = Z + (size_t)cl * 128 * ZW + head * 128;
#pragma unroll
    for (int i = 0; i < 4; ++i) {
        const int p = tid + 512 * i, row = p >> 4, col = (p & 15) * 8;
        const u32x4 kv = *(const u32x4*)(zr + (size_t)row * ZW + C_RK + col);
        const u32x4 vv = *(const u32x4*)(zr + (size_t)row * ZW + C_RV + col);
        const int off = v_st(row, col);
        *(LAS u32x4*)(Kimg + off) = kv;
        f32x4 a, b; unpack8(vv, a, b);
        const float zf = __builtin_amdgcn_exp2f(lf * (float)(127 - row)), zb = __builtin_amdgcn_exp2f(lb * (float)row);
        *(LAS u32x4*)(Vf + off) = pack8(a * zf, b * zf);
        *(LAS u32x4*)(Vb + off) = pack8(a * zb, b * zb);
    }
    __syncthreads();
    const int ab = wid & 3, b0 = 2 * (wid >> 2);
    const int rb = v_rd_base(lane);
    const int ka = (int)(uintptr_t)Kimg + rb + ab * 512, vfa = (int)(uintptr_t)Vf + rb + b0 * 512, vba = (int)(uintptr_t)Vb + rb + b0 * 512;
    f32x16 aF0 = {}, aF1 = {}, aB0 = {}, aB1 = {};
#define RETA_STEP(KS) do { \
        const s16x4 al = tr_read<v_rd_off(0, KS, 0)>(ka), ah = tr_read<v_rd_off(0, KS, 1)>(ka); \
        const s16x4 f0l = tr_read<v_rd_off(0, KS, 0)>(vfa), f0h = tr_read<v_rd_off(0, KS, 1)>(vfa), f1l = tr_read<v_rd_off(1, KS, 0)>(vfa), f1h = tr_read<v_rd_off(1, KS, 1)>(vfa); \
        const s16x4 g0l = tr_read<v_rd_off(0, KS, 0)>(vba), g0h = tr_read<v_rd_off(0, KS, 1)>(vba), g1l = tr_read<v_rd_off(1, KS, 0)>(vba), g1h = tr_read<v_rd_off(1, KS, 1)>(vba); \
        LGKM0(); SBAR(); \
        const bf16x8 A = PKF(al, ah); \
        aF0 = MFMA32(A, PKF(f0l, f0h), aF0); aF1 = MFMA32(A, PKF(f1l, f1h), aF1); aB0 = MFMA32(A, PKF(g0l, g0h), aB0); aB1 = MFMA32(A, PKF(g1l, g1h), aB1); } while (0)
    RETA_STEP(0); RETA_STEP(1); RETA_STEP(2); RETA_STEP(3); RETA_STEP(4); RETA_STEP(5); RETA_STEP(6); RETA_STEP(7);
#undef RETA_STEP
    bf16_t* sf = ST + ((size_t)(cl * 4 + head) * 2) * 16384; bf16_t* sb = sf + 16384;
#pragma unroll
    for (int r = 0; r < 16; ++r) {
        const int dk = 32 * ab + crow(r, hi); const int o = dk * 128 + 32 * b0 + r32;
        sf[o] = (bf16_t)(cvt_pk(aF0[r], 0.f) & 0xffff); sf[o + 32] = (bf16_t)(cvt_pk(aF1[r], 0.f) & 0xffff);
        sb[o] = (bf16_t)(cvt_pk(aB0[r], 0.f) & 0xffff); sb[o + 32] = (bf16_t)(cvt_pk(aB1[r], 0.f) & 0xffff);
    }
    __syncthreads();
}

DI void seq_chunks(int g, int s, int& c0, int& n) {
    if (g == 0) { c0 = s * 16; n = 16; }
    else if (s < 8) { c0 = s * 16; n = 16; }
    else { c0 = 128 + (s - 8) * 32; n = 32; }
}
constexpr int nseq_of(int g) { return g == 0 ? 24 : 16; }

DI void ret_scan(bf16_t* ST, int g, int gtid, int gthreads) {
    const int total = nseq_of(g) * 4 * 2 * 2048;
    for (int i = gtid; i < total; i += gthreads) {
        const int e8 = i & 2047, dir = (i >> 11) & 1, head = (i >> 12) & 3, s = i >> 14;
        int c0, n; seq_chunks(g, s, c0, n);
        const float dec = __builtin_amdgcn_exp2f(128.f * (dir ? LOG2G_B[head] : LOG2G_F[head]));
        f32x4 s0 = {0.f, 0.f, 0.f, 0.f}, s1 = {0.f, 0.f, 0.f, 0.f};
        bf16_t* base = ST + ((size_t)(c0 * 4 + head) * 2 + dir) * 16384 + e8 * 8;
        for (int cb = 0; cb < n; cb += 16) {
            u32x4 a[16];
#pragma unroll
            for (int k = 0; k < 16; ++k) { const int cc = dir ? (n - 1 - (cb + k)) : (cb + k); a[k] = *(const u32x4*)(base + (size_t)cc * 131072); }
#pragma unroll
            for (int k = 0; k < 16; ++k) { const int cc = dir ? (n - 1 - (cb + k)) : (cb + k);
                f32x4 x, y; unpack8(a[k], x, y);
                *(u32x4*)(base + (size_t)cc * 131072) = pack8(s0, s1);
                s0 = s0 * dec + x; s1 = s1 * dec + y; }
        }
    }
}

#define KSWZ(row, colB) ((row) * 256 + ((colB) ^ (((row) & 7) << 4)))
DI void pk4f(const f32x16& P, int base, bf16x8& out) {
    unsigned a0 = cvt_pk(P[base + 0], P[base + 1]), a1 = cvt_pk(P[base + 2], P[base + 3]);
    unsigned b0 = cvt_pk(P[base + 4], P[base + 5]), b1 = cvt_pk(P[base + 6], P[base + 7]);
    auto r0 = __builtin_amdgcn_permlane32_swap(a0, b0, false, false); auto r1 = __builtin_amdgcn_permlane32_swap(a1, b1, false, false);
    u32x4 w = {r0[0], r1[0], r0[1], r1[1]}; out = *reinterpret_cast<bf16x8*>(&w);
}
template <int D0> DI void tr_mma4(f32x16& od, int vb, bf16x8 a0, bf16x8 a1, bf16x8 a2, bf16x8 a3) {
    const s16x4 l0 = tr_read<v_rd_off(D0, 0, 0)>(vb), h0 = tr_read<v_rd_off(D0, 0, 1)>(vb), l1 = tr_read<v_rd_off(D0, 1, 0)>(vb), h1 = tr_read<v_rd_off(D0, 1, 1)>(vb);
    const s16x4 l2 = tr_read<v_rd_off(D0, 2, 0)>(vb), h2 = tr_read<v_rd_off(D0, 2, 1)>(vb), l3 = tr_read<v_rd_off(D0, 3, 0)>(vb), h3 = tr_read<v_rd_off(D0, 3, 1)>(vb);
    LGKM0(); SBAR();
    od = MFMA32(a0, PKF(l0, h0), od); od = MFMA32(a1, PKF(l1, h1), od); od = MFMA32(a2, PKF(l2, h2), od); od = MFMA32(a3, PKF(l3, h3), od);
}
DI bf16x8 scale8(bf16x8 q, float s) {
    const u32x4 w = *reinterpret_cast<const u32x4*>(&q); f32x4 a, b; unpack8(w, a, b); const u32x4 o = pack8(a * s, b * s); return *reinterpret_cast<const bf16x8*>(&o);
}
DI void retO_unit(LAS unsigned char* lds, bf16_t* Z, const bf16_t* ST, const float* gn_g, int cl, int head, const int tid, const bool store) {
    const int wid = __builtin_amdgcn_readfirstlane(tid >> 6), lane = tid & 63, r32 = lane & 31, hi = lane >> 5;
    LAS unsigned char* Ks = lds; LAS unsigned char* Vi = lds + 32768; LAS unsigned char* Sfi = lds + 65536; LAS unsigned char* Sbi = lds + 98304;
    const float lf = LOG2G_F[head], lb = LOG2G_B[head];
    bf16_t* zr = Z + (size_t)cl * 128 * ZW + head * 128;
    const bf16_t* sf = ST + ((size_t)(cl * 4 + head) * 2) * 16384; const bf16_t* sb = sf + 16384;
#pragma unroll
    for (int i = 0; i < 4; ++i) {
        const int p = tid + 512 * i, row = p >> 4, col = (p & 15) * 8;
        const u32x4 kv = *(const u32x4*)(zr + (size_t)row * ZW + C_RK + col);
        const u32x4 vv = *(const u32x4*)(zr + (size_t)row * ZW + C_RV + col);
        const u32x4 s1 = *(const u32x4*)(sf + row * 128 + col);
        const u32x4 s2 = *(const u32x4*)(sb + row * 128 + col);
        const int off = v_st(row, col);
        *(LAS u32x4*)(Ks + KSWZ(row, col * 2)) = kv;
        *(LAS u32x4*)(Vi + off) = vv; *(LAS u32x4*)(Sfi + off) = s1; *(LAS u32x4*)(Sbi + off) = s2;
    }
    const int wq = wid & 3, wk = wid >> 2;
    const int qi = 32 * wq + r32;
    bf16x8 qr[8];
    const bf16_t* qp = zr + (size_t)qi * ZW + C_RQ + hi * 8;
#pragma unroll
    for (int d0 = 0; d0 < 8; ++d0) qr[d0] = *(const bf16x8*)(qp + d0 * 16);
    bf16x8 qx[4];
#pragma unroll
    for (int s = 0; s < 4; ++s) qx[s] = *(const bf16x8*)(qp + (4 * wk + s) * 16);
    __syncthreads();
    f32x16 p0 = {}, p1 = {};
    {
        LAS const unsigned char* Kb = Ks + (64 * wk) * 256;
#pragma unroll
        for (int d0 = 0; d0 < 8; ++d0) { const int cb = (d0 * 16 + hi * 8) * 2;
            const bf16x8 b0 = *(const LAS bf16x8*)(Kb + KSWZ(r32, cb)); const bf16x8 b1 = *(const LAS bf16x8*)(Kb + KSWZ(32 + r32, cb));
            p0 = MFMA32(b0, qr[d0], p0); p1 = MFMA32(b1, qr[d0], p1); }
    }
#pragma unroll
    for (int r = 0; r < 16; ++r) {
        const int j0 = 64 * wk + crow(r, hi), j1 = j0 + 32;
        const float d0 = (float)(qi - j0), d1 = (float)(qi - j1);
        p0[r] *= __builtin_amdgcn_exp2f(d0 >= 0.f ? lf * d0 : -lb * d0);
        p1[r] *= __builtin_amdgcn_exp2f(d1 >= 0.f ? lf * d1 : -lb * d1);
    }
    bf16x8 pa0, pa1, pa2, pa3; pk4f(p0, 0, pa0); pk4f(p0, 8, pa1); pk4f(p1, 0, pa2); pk4f(p1, 8, pa3);
    f32x16 o[4] = {};
    const int rb = v_rd_base(lane) + wk * (4 * 4096);
    const int va = (int)(uintptr_t)Vi + rb, sfa = (int)(uintptr_t)Sfi + rb, sba = (int)(uintptr_t)Sbi + rb;
    tr_mma4<0>(o[0], va, pa0, pa1, pa2, pa3); tr_mma4<1>(o[1], va, pa0, pa1, pa2, pa3); tr_mma4<2>(o[2], va, pa0, pa1, pa2, pa3); tr_mma4<3>(o[3], va, pa0, pa1, pa2, pa3);
    {
        const float xf = __builtin_amdgcn_exp2f(lf * (float)(qi + 1));
        const bf16x8 a0 = scale8(qx[0], xf), a1 = scale8(qx[1], xf), a2 = scale8(qx[2], xf), a3 = scale8(qx[3], xf);
        tr_mma4<0>(o[0], sfa, a0, a1, a2, a3); tr_mma4<1>(o[1], sfa, a0, a1, a2, a3); tr_mma4<2>(o[2], sfa, a0, a1, a2, a3); tr_mma4<3>(o[3], sfa, a0, a1, a2, a3);
    }
    {
        const float xb = __builtin_amdgcn_exp2f(lb * (float)(128 - qi));
        const bf16x8 a0 = scale8(qx[0], xb), a1 = scale8(qx[1], xb), a2 = scale8(qx[2], xb), a3 = scale8(qx[3], xb);
        tr_mma4<0>(o[0], sba, a0, a1, a2, a3); tr_mma4<1>(o[1], sba, a0, a1, a2, a3); tr_mma4<2>(o[2], sba, a0, a1, a2, a3); tr_mma4<3>(o[3], sba, a0, a1, a2, a3);
    }
    __syncthreads();
    const int nrow = tid >> 2, nqd = tid & 3;
    bf16_t* gp = zr + (size_t)nrow * ZW + C_RG + nqd * 32; const float* gg = gn_g + head * 128 + nqd * 32;
    u32x4 gv[4]; f32x4 gw[8];
#pragma unroll
    for (int i = 0; i < 4; ++i) { gv[i] = *(const u32x4*)(gp + i * 8); gw[2 * i] = *(const f32x4*)(gg + i * 8); gw[2 * i + 1] = *(const f32x4*)(gg + i * 8 + 4); }
    LAS float* Ob = (LAS float*)lds;
    if (wk == 1) {
#pragma unroll
        for (int d0 = 0; d0 < 4; ++d0)
#pragma unroll
            for (int r = 0; r < 16; ++r) Ob[(32 * wq + crow(r, hi)) * 132 + 32 * d0 + r32] = o[d0][r];
    }
    __syncthreads();
    if (wk == 0) {
#pragma unroll
        for (int d0 = 0; d0 < 4; ++d0)
#pragma unroll
            for (int r = 0; r < 16; ++r) { LAS float* p = Ob + (32 * wq + crow(r, hi)) * 132 + 32 * d0 + r32; *p = *p + o[d0][r]; }
    }
    __syncthreads();
    {
        const int row = nrow, qd = nqd;
        f32x4 v[8]; float s = 0.f;
#pragma unroll
        for (int i = 0; i < 8; ++i) { v[i] = *(LAS f32x4*)(Ob + row * 132 + qd * 32 + i * 4); s += (v[i][0] + v[i][1]) + (v[i][2] + v[i][3]); }
        s += swz_xor<1>(s); s += swz_xor<2>(s);
        const float mu = s * (1.f / 128.f); float q = 0.f;
#pragma unroll
        for (int i = 0; i < 8; ++i) { v[i] = v[i] - mu; q += (v[i][0] * v[i][0] + v[i][1] * v[i][1]) + (v[i][2] * v[i][2] + v[i][3] * v[i][3]); }
        q += swz_xor<1>(q); q += swz_xor<2>(q);
        const float rstd = __builtin_amdgcn_rsqf(q * (1.f / 128.f) + EPS);
#pragma unroll
        for (int i = 0; i < 4; ++i) {
            f32x4 ga, gb; unpack8(gv[i], ga, gb);
            if (store || rstd == 1.2345e-33f) *(u32x4*)(gp + i * 8) = pack8(v[2 * i] * rstd * gw[2 * i] * ga, v[2 * i + 1] * rstd * gw[2 * i + 1] * gb);
        }
    }
    __syncthreads();
}

namespace att {
constexpr int NW = 8, QBLK = 32, KVBLK = 64;
constexpr float SCALE = 0.07216878364870322f;
constexpr float THR = 8.f;
constexpr int SHM_V = KVBLK * 128 * 2, SHM_KN = KVBLK * 128 * 2, SHM_KP = KVBLK * 64 * 2;
constexpr int OFF_V = 0, OFF_KN = 2 * SHM_V, OFF_KP = OFF_KN + 2 * SHM_KN, OFF_WS = OFF_KP + 2 * SHM_KP, OFF_QP = OFF_WS + 2048;
#define PSWZ(row, colB) ((row) * 128 + ((colB) ^ ((((row) >> 1) & 7) << 4)))
DI void partialSM(f32x16& p0, f32x16& p1, float& m_reg, float& mn, float& alpha) {
    constexpr float C = SCALE * 1.4426950408889634f;
    float pmax = p0[0];
#pragma unroll
    for (int r = 1; r < 16; ++r) pmax = fmaxf(pmax, p0[r]);
#pragma unroll
    for (int r = 0; r < 16; ++r) pmax = fmaxf(pmax, p1[r]);
    { auto rr = __builtin_amdgcn_permlane32_swap(__float_as_uint(pmax), __float_as_uint(pmax), false, false);
      pmax = fmaxf(__uint_as_float(rr[0]), __uint_as_float(rr[1])); }
    if (__builtin_expect(__all(pmax - m_reg <= THR / SCALE), 1)) { mn = m_reg; alpha = 1.f; }
    else { mn = fmaxf(m_reg, pmax); alpha = __builtin_amdgcn_exp2f((m_reg - mn) * C); m_reg = mn; }
    const float mnC = -mn * C;
#pragma unroll
    for (int r = 0; r < 16; ++r) p0[r] = fmaf(p0[r], C, mnC);
#pragma unroll
    for (int r = 0; r < 16; ++r) p1[r] = fmaf(p1[r], C, mnC);
#pragma unroll
    for (int r = 0; r < 16; ++r) p0[r] = __builtin_amdgcn_exp2f(p0[r]);
}
DI void finishSM(f32x16& p0, f32x16& p1, float alpha, float& l_reg, bf16x8& pa0, bf16x8& pa1, bf16x8& pa2, bf16x8& pa3) {
#pragma unroll
    for (int r = 0; r < 16; ++r) p1[r] = __builtin_amdgcn_exp2f(p1[r]);
    float ps = 0;
#pragma unroll
    for (int r = 0; r < 16; ++r) ps += p0[r];
#pragma unroll
    for (int r = 0; r < 16; ++r) ps += p1[r];
    { auto rr = __builtin_amdgcn_permlane32_swap(__float_as_uint(ps), __float_as_uint(ps), false, false);
      ps = __uint_as_float(rr[0]) + __uint_as_float(rr[1]); }
    l_reg = l_reg * alpha + ps;
    pk4f(p0, 0, pa0); pk4f(p0, 8, pa1); pk4f(p1, 0, pa2); pk4f(p1, 8, pa3);
}
#define KFRAG(HALF, D0) ((D0) < 8 ? *(const LAS bf16x8*)(Kn + KSWZ((HALF) * 32 + r32, (((D0) & 7) * 16 + hi * 8) * 2)) : *(const LAS bf16x8*)(Kp + PSWZ((HALF) * 32 + r32, ((((D0) - 8) & 3) * 16 + hi * 8) * 2)))
DI void qkt(f32x16& p0, f32x16& p1, LAS const unsigned char* Kn, LAS const unsigned char* Kp, const bf16x8* qr, LAS const unsigned char* qpl, int r32, int hi) {
    p0 = f32x16{}; p1 = f32x16{};
    bf16x8 fa0 = KFRAG(0, 0), fa1 = KFRAG(1, 0), fb0 = KFRAG(0, 1), fb1 = KFRAG(1, 1);
#pragma unroll
    for (int d0 = 0; d0 < 12; ++d0) {
        bf16x8 fc0 = fa0, fc1 = fa1;
        if (d0 + 2 < 12) { fc0 = KFRAG(0, d0 + 2); fc1 = KFRAG(1, d0 + 2); }
        SBAR();
        p0 = MFMA32(fa0, qr[d0], p0); p1 = MFMA32(fa1, qr[d0], p1);
        SBAR();
        fa0 = fb0; fa1 = fb1; fb0 = fc0; fb1 = fc1;
    }
}
DI void pv_d0(f32x16* o, int vb, bf16x8 pa0, bf16x8 pa1, bf16x8 pa2, bf16x8 pa3) {
    tr_mma4<0>(o[0], vb, pa0, pa1, pa2, pa3); tr_mma4<1>(o[1], vb, pa0, pa1, pa2, pa3); tr_mma4<2>(o[2], vb, pa0, pa1, pa2, pa3); tr_mma4<3>(o[3], vb, pa0, pa1, pa2, pa3);
}
DI void attn_unit(const bf16_t* __restrict__ Qb, const bf16_t* __restrict__ Knh, const bf16_t* __restrict__ Vh, const bf16_t* __restrict__ Kph, bf16_t* Og, int seq, LAS unsigned char* lds, const int tid, const int wid, const bool store) {
    const int  lane = tid & 63, r32 = lane & 31, hi = lane >> 5;
    LAS unsigned char* V_lds = lds + OFF_V; LAS unsigned char* Kn_lds = lds + OFF_KN; LAS unsigned char* Kp_lds = lds + OFF_KP;
    LAS float* ws = (LAS float*)(lds + OFF_WS) + wid * 64; LAS float* li_l = ws; LAS float* al_l = ws + 32;
    float m_reg = -1e30f, l_reg = 0; f32x16 o[4] = {}; bf16x8 qr[12];
    LAS unsigned char* qpl = lds + OFF_QP + wid * 8192 + lane * 16;
    const bf16_t* Qw = Qb + (long)(wid * QBLK + r32) * QW + hi * 8;
#pragma unroll
    for (int d0 = 0; d0 < 12; ++d0) qr[d0] = *(const bf16x8*)(Qw + d0 * 16);
    const int sr = tid >> 4, sc = (tid & 15) * 8, vst0 = v_st(sr, sc), vst1 = v_st(32 + sr, sc);
    const int pr = tid >> 3, pc = (tid & 7) * 8;
    const int vb0 = (int)(uintptr_t)V_lds + v_rd_base(lane);
    bf16x8 vs0, vs1, ks0, ks1, kp0;
    const unsigned voff = (unsigned)(sr * QW + sc), poff = (unsigned)(pr * ZW + pc);
#define SLOAD(k0) do { const bf16_t* kb0_ = Knh + (size_t)(k0) * QW; const bf16_t* kb1_ = kb0_ + 32 * QW; const bf16_t* kpb_ = Kph + (size_t)(k0) * ZW; \
    ks0 = *(const bf16x8*)(kb0_ + voff); ks1 = *(const bf16x8*)(kb1_ + voff); vs0 = *(const bf16x8*)(kb0_ + 128 + voff); vs1 = *(const bf16x8*)(kb1_ + 128 + voff); \
    kp0 = *(const bf16x8*)(kpb_ + poff); } while (0)
#define SWRITE(b) do { *(LAS bf16x8*)(V_lds + (b) * SHM_V + vst0) = vs0; *(LAS bf16x8*)(V_lds + (b) * SHM_V + vst1) = vs1; const int kc = sc * 2; \
    *(LAS bf16x8*)(Kn_lds + (b) * SHM_KN + KSWZ(sr, kc)) = ks0; *(LAS bf16x8*)(Kn_lds + (b) * SHM_KN + KSWZ(32 + sr, kc)) = ks1; \
    *(LAS bf16x8*)(Kp_lds + (b) * SHM_KP + PSWZ(pr, pc * 2)) = kp0; } while (0)
#define SWAIT() asm volatile("s_waitcnt vmcnt(0)" ::: "memory")
#define RESC(a) do { if (__any((a) < 1.f)) { if (hi == 0) al_l[r32] = (a); LGKM0(); \
    _Pragma("unroll") for (int d = 0; d < 4; ++d) _Pragma("unroll") for (int r = 0; r < 16; ++r) o[d][r] *= al_l[crow(r, hi)]; } } while (0)
    f32x16 pA0, pA1; float mnA, alA; bf16x8 pa0, pa1, pa2, pa3; const int NT = seq / KVBLK;
    SLOAD(0); SWAIT(); SWRITE(0); __syncthreads();
    for (int j = 0; j < NT; ++j) {
        const int buf = j & 1;
        if (j + 1 < NT) SLOAD((j + 1) * KVBLK);
        SBAR();
        qkt(pA0, pA1, Kn_lds + buf * SHM_KN, Kp_lds + buf * SHM_KP, qr, qpl, r32, hi);
        partialSM(pA0, pA1, m_reg, mnA, alA);
        finishSM(pA0, pA1, alA, l_reg, pa0, pa1, pa2, pa3);
        RESC(alA); SBAR();
        pv_d0(o, vb0 + buf * SHM_V, pa0, pa1, pa2, pa3);
        if (j + 1 < NT) { SWAIT(); SWRITE(buf ^ 1); }
        __syncthreads();
    }
    if (hi == 0) li_l[r32] = l_reg; LGKM0();
    float rli[16];
#pragma unroll
    for (int r = 0; r < 16; ++r) rli[r] = __builtin_amdgcn_rcpf(li_l[crow(r, hi)]);
    bf16_t* Ow = Og + (long)(wid * QBLK) * ZW;
    if (store || rli[0] == 1.2345e-33f) {
        bf16_t gt[16][4];
#pragma unroll
        for (int r = 0; r < 16; ++r)
#pragma unroll
            for (int d0 = 0; d0 < 4; ++d0) gt[r][d0] = Ow[(long)crow(r, hi) * ZW + d0 * 32 + r32];
        asm volatile("" ::: "memory");
#pragma unroll
        for (int r = 0; r < 16; ++r)
#pragma unroll
            for (int d0 = 0; d0 < 4; ++d0) { const float gate = __uint_as_float((unsigned)gt[r][d0] << 16);
                Ow[(long)crow(r, hi) * ZW + d0 * 32 + r32] = (bf16_t)(cvt_pk(o[d0][r] * rli[r] * gate, 0.f) & 0xffff); }
    }
    __syncthreads();
#undef SLOAD
#undef SWRITE
#undef SWAIT
#undef RESC
}
}

DI void prep_all(const Params& p, unsigned char* ws, int gtid, int gthreads) {
    for (int i = gtid; i < 4096 * 64; i += gthreads) {
        const int pos = i >> 6, f = i & 63;
        const float inv = exp2f(-(float)(2 * f) * (1.f / 128.f) * 13.287712379549449f);
        const double ang = (double)((float)pos * inv) * 0.15915494309189535;
        const float fr = (float)(ang - rint(ang));
        ((float*)(ws + WS_COSR))[i] = __builtin_amdgcn_cosf(fr); ((float*)(ws + WS_SINR))[i] = __builtin_amdgcn_sinf(fr);
    }
    for (int i = gtid; i < 4096 * 32; i += gthreads) {
        const int pos = i >> 5, f = i & 31;
        const float inv = exp2f(-(float)(2 * f) * (1.f / 64.f) * 13.287712379549449f);
        const double ang = (double)((float)pos * inv) * 0.15915494309189535;
        const float fr = (float)(ang - rint(ang));
        ((float*)(ws + WS_COSM))[i] = __builtin_amdgcn_cosf(fr); ((float*)(ws + WS_SINM))[i] = __builtin_amdgcn_sinf(fr);
    }
    for (int l = 0; l < DEPTH; ++l) {
        {
            const float* W = p.w_in + (size_t)l * DM * IN_W; bf16_t* Bt = (bf16_t*)(ws + WS_WIN + l * SZ_WIN);
            for (int i = gtid; i < NV * (DM / 8); i += gthreads) {
                const int R = i % NV, k0 = (i / NV) * 8; const int v = (R & ~31) + pg8::perm32(R & 31); const int src = colsrc_in(v);
                float x[8];
#pragma unroll
                for (int j = 0; j < 8; ++j) x[j] = src >= 0 ? W[(size_t)(k0 + j) * IN_W + src] * (l == 1 ? p.norm_g[DM + k0 + j] : 1.f) : 0.f;
                u32x4 o; o.x = cvt_pk(x[0], x[1]); o.y = cvt_pk(x[2], x[3]); o.z = cvt_pk(x[4], x[5]); o.w = cvt_pk(x[6], x[7]);
                *(u32x4*)(Bt + (size_t)R * DM + k0) = o;
            }
        }
        {
            const float* Wq = p.w_uq + (size_t)l * 256 * 768; const float* Wkv = p.w_ukv + (size_t)l * 128 * 1024;
            const float* gq = p.q_norm_g + l * 256; const float* gkv = p.kv_norm_g + l * 128; bf16_t* Bt = (bf16_t*)(ws + WS_WQKV + l * SZ_WQKV);
            for (int i = gtid; i < QW * (KQKV / 8); i += gthreads) {
                const int R = i % QW, k0 = (i / QW) * 8; const int v = (R & ~31) + pg8::perm32(R & 31);
                float x[8];
#pragma unroll
                for (int j = 0; j < 8; ++j) { const int k = k0 + j;
                    if (v < 768) x[j] = Wq[(size_t)k * 768 + colsrc_q(v)] * gq[k];
                    else x[j] = k < 128 ? Wkv[(size_t)k * 1024 + (v - 768)] * gkv[k] : 0.f; }
                u32x4 o; o.x = cvt_pk(x[0], x[1]); o.y = cvt_pk(x[2], x[3]); o.z = cvt_pk(x[4], x[5]); o.w = cvt_pk(x[6], x[7]);
                *(u32x4*)(Bt + (size_t)R * KQKV + k0) = o;
            }
        }
        for (int which = 0; which < 2; ++which) {
            bf16_t* Bt = which == 1 ? (bf16_t*)(ws + WS_WOUT + l * SZ_WOUT) : (bf16_t*)(ws + WS_WBR + l * 2 * SZ_WBR);
            for (int i = gtid; i < 1024 * (1024 / 8); i += gthreads) {
                const int R = i % 1024, k0 = (i / 1024) * 8; const int v = (R & ~31) + pg8::perm32(R & 31);
                const float* W = which == 1 ? p.w_out + (size_t)l * 1024 * 1024 + (size_t)k0 * 1024
                               : (k0 < 512 ? p.w_br_ret + (size_t)l * 512 * 1024 + (size_t)k0 * 1024 : p.w_br_mla + (size_t)l * 512 * 1024 + (size_t)(k0 - 512) * 1024);
                float x[8];
#pragma unroll
                for (int j = 0; j < 8; ++j) x[j] = W[(size_t)j * 1024 + v];
                u32x4 o; o.x = cvt_pk(x[0], x[1]); o.y = cvt_pk(x[2], x[3]); o.z = cvt_pk(x[4], x[5]); o.w = cvt_pk(x[6], x[7]);
                *(u32x4*)(Bt + (size_t)R * 1024 + k0) = o;
            }
        }
    }
}

#define XB_TMO      128
#define XB_XCNT(j)  (256  + 64 * (j))
#define XB_XSUB(j)  (1280 + 64 * (j))
#define XB_XGEN(j)  (2304 + 64 * (j))
#define XB_TOP      3328
#define XB_TOPGEN   3392
#define XCD_BAR_WORDS 3456
#define XB_SPIN_CAP (1u << 18)

__device__ __forceinline__ unsigned xb_ld(unsigned* p)              { return __hip_atomic_load(p, __ATOMIC_RELAXED, __HIP_MEMORY_SCOPE_AGENT); }
__device__ __forceinline__ unsigned xb_add(unsigned* p, unsigned v) { return __hip_atomic_fetch_add(p, v, __ATOMIC_RELAXED, __HIP_MEMORY_SCOPE_AGENT); }
__device__ __forceinline__ unsigned xb_xcc_id() { return (unsigned)__builtin_amdgcn_s_getreg((3 << 11) | 20) & 0xFu; }
#define XB_SPIN(cond, bar) do { unsigned _sp = 0; while (cond) { __builtin_amdgcn_s_sleep(1); \
    if ((++_sp & 255u) == 0u) { if (xb_ld(&(bar)[XB_TMO])) break; if (_sp > XB_SPIN_CAP) { atomicAdd(&(bar)[XB_TMO], 1u); break; } } } } while (0)

struct XcdBarrier {
    unsigned* bar; unsigned x;
    volatile LAS unsigned* st;
};

__device__ __forceinline__ XcdBarrier xcd_barrier_post(unsigned* bar, volatile LAS unsigned* st) {
    XcdBarrier b; b.bar = bar; b.x = xb_xcc_id(); b.st = st;
    if (threadIdx.x == 0) (void)xb_add(&bar[XB_XCNT(b.x)], 1u);
    return b;
}
__device__ __forceinline__ void xcd_barrier_complete(unsigned* bar, unsigned x, unsigned& nloc, unsigned& nx) {
    const unsigned G = gridDim.x * gridDim.y * gridDim.z;
    unsigned sum, cnt, mine, sp = 0u;
    for (;;) {
        sum = 0u; cnt = 0u; mine = 0u;
#pragma unroll
        for (unsigned j = 0; j < 16; ++j) { const unsigned c = xb_ld(&bar[XB_XCNT(j)]); sum += c; cnt += (c > 0u) ? 1u : 0u; mine = (j == x) ? c : mine; }
        if (sum == G) break;
        __builtin_amdgcn_s_sleep(1);
        if ((++sp & 255u) == 0u) { if (xb_ld(&bar[XB_TMO])) break; if (sp > XB_SPIN_CAP) { atomicAdd(&bar[XB_TMO], 1u); break; } }
    }
    nloc = mine > 0u ? mine : 1u; nx = cnt > 0u ? cnt : 1u;
}

__device__ __forceinline__ void xcd_barrier(const XcdBarrier& b, const bool t0) {
    asm volatile("s_waitcnt vmcnt(0)" ::: "memory");
    __syncthreads();
    if (t0) {
        unsigned* bar = b.bar;
        __builtin_amdgcn_s_waitcnt(0);
        unsigned nloc = b.st[0], nx = b.st[1];
        if (nloc == 0u) { xcd_barrier_complete(bar, b.x, nloc, nx); b.st[0] = nloc; b.st[1] = nx; }
        const unsigned old = xb_add(&bar[XB_XSUB(b.x)], 1u);
        const unsigned gen = old / nloc;
        if (old + 1u == (gen + 1u) * nloc) {
            __builtin_amdgcn_fence(__ATOMIC_RELEASE, "agent");
            asm volatile("s_waitcnt vmcnt(0)" ::: "memory");
            const unsigned og = xb_add(&bar[XB_TOP], 1u);
            const unsigned tg = og / nx;
            if (og + 1u == (tg + 1u) * nx) xb_add(&bar[XB_TOPGEN], 1u);
            else XB_SPIN(xb_ld(&bar[XB_TOPGEN]) == tg, bar);
            __builtin_amdgcn_fence(__ATOMIC_ACQUIRE, "agent");
            xb_add(&bar[XB_XGEN(b.x)], 1u);
            asm volatile("s_waitcnt vmcnt(0)" ::: "memory");
        } else {
            XB_SPIN(xb_ld(&bar[XB_XGEN(b.x)]) == gen, bar);
            __builtin_amdgcn_fence(__ATOMIC_ACQUIRE, "agent");
            asm volatile("s_waitcnt vmcnt(0)" ::: "memory");
        }
    }
    __syncthreads();
}

#define FINAL_NORM(TLO, THI) do { const float* gfin = p.final_norm_g; \
    const f32x4 g0 = *(const f32x4*)(gfin + 8 * lane), g1 = *(const f32x4*)(gfin + 8 * lane + 4), g2 = *(const f32x4*)(gfin + 512 + 8 * lane), g3 = *(const f32x4*)(gfin + 512 + 8 * lane + 4); \
    for (int r0 = gw; r0 < TG; r0 += 2 * NGW) { u32x4 w0[2], w1[2]; float rsx[2]; \
        _Pragma("unroll") for (int k = 0; k < 2; ++k) { const int r = (r0 + k * NGW) < TG ? (r0 + k * NGW) : r0; \
            w0[k] = *(const u32x4*)(XB + (size_t)r * DM + 8 * lane); w1[k] = *(const u32x4*)(XB + (size_t)r * DM + 512 + 8 * lane); rsx[k] = row_scale(SSQ, r); } \
        asm volatile("" ::: "memory"); \
        _Pragma("unroll") for (int k = 0; k < 2; ++k) { const int r = r0 + k * NGW; if (r < TG) { float* yr = p.out + (size_t)((TLO) + r) * DM; const float rs = rsx[k]; \
            f32x4 a0, a1, b0, b1; unpack8(w0[k], a0, a1); unpack8(w1[k], b0, b1); \
            *(f32x4*)(yr + 8 * lane) = a0 * rs * g0; *(f32x4*)(yr + 8 * lane + 4) = a1 * rs * g1; *(f32x4*)(yr + 512 + 8 * lane) = b0 * rs * g2; *(f32x4*)(yr + 512 + 8 * lane + 4) = b1 * rs * g3; } } } } while (0)
constexpr int PH_PER = 7, N_PHASES = 1 + DEPTH * NG * PH_PER + 1;

__global__ void __launch_bounds__(512) mega_fwd(Params p) {
    extern __shared__ __attribute__((aligned(16))) unsigned char lds_raw[];
    LAS unsigned char* lds = (LAS unsigned char*)lds_raw;
    cg::grid_group grid = cg::this_grid();
    volatile LAS unsigned* bst = (volatile LAS unsigned*)(lds + LDS_BYTES - 16);
    if (threadIdx.x < 4) bst[threadIdx.x] = 0u;
    __syncthreads();
    (void)xcd_barrier_post((unsigned*)(p.ws + WS_CTL), bst);
    int wave_s = __builtin_amdgcn_readfirstlane(threadIdx.x >> 6); asm volatile("" : "+s"(wave_s));
    for (int ph = p.ph_lo; ph < p.ph_hi; ++ph) {
    int neg1 = -1; asm volatile("" : "+s"(neg1));
    int tid = wave_s * 64 + (int)__builtin_amdgcn_mbcnt_hi(neg1, __builtin_amdgcn_mbcnt_lo(neg1, 0)); asm volatile("" : "+v"(tid));
    size_t zoff = 0; asm volatile("" : "+s"(zoff));
    unsigned char* ws = p.ws + zoff;
    int G = gridDim.x, bx = blockIdx.x; asm volatile("" : "+s"(G), "+s"(bx));
    const int vcu = (G % 8 == 0) ? (bx % 8) * (G / 8) + bx / 8 : bx;
#define lane (tid & 63)
#define gtid (bx * 512 + tid)
#define gthreads (G * 512)
#define gw (vcu * 8 + wave_s)
#define NGW (G * 8)
    bf16_t* H = (bf16_t*)(ws + WS_H); bf16_t* ST = H; bf16_t* Z = (bf16_t*)(ws + WS_Z); bf16_t* QKV = (bf16_t*)(ws + WS_QKV); float* RS = (float*)(ws + WS_RS);
    bf16_t* XB = (bf16_t*)(ws + WS_XB); float* SSQ = (float*)(ws + WS_SSQ); float* RS1 = (float*)(ws + WS_RS1);
    const float* cosR = (const float*)(ws + WS_COSR); const float* sinR = (const float*)(ws + WS_SINR);
    const float* cosM = (const float*)(ws + WS_COSM); const float* sinM = (const float*)(ws + WS_SINM);
        if (ph == 0) {
            if (EN(100)) prep_all(p, ws, gtid, gthreads);
            if (PROBE == 8) prep_all(p, ws, gtid, gthreads);
        } else if (ph == N_PHASES - 1 && EN(101)) {
            FINAL_NORM(T_ALL - TG, T_ALL);
        } else {
            const int q = ph - 1, g = q / (DEPTH * PH_PER), l = (q / PH_PER) % DEPTH, sub = q % PH_PER;
            const int t0 = g * TG;
            if (sub == 0 && l == 1) {
                for (int r = gtid; r < TG; r += gthreads) RS1[r] = row_scale(SSQ, r);
            } else
            if (sub == 0 && EN(0)) {
                const float* gn = p.norm_g + l * DM;
                f32x4 gg[4];
#pragma unroll
                for (int j = 0; j < 4; ++j) gg[j] = *(const f32x4*)(gn + 256 * j + 4 * lane);
                for (int r0 = gw; r0 < TG; r0 += 4 * NGW) {
                    f32x4 v[4][4];
#pragma unroll
                    for (int k = 0; k < 4; ++k) { const int r = r0 + k * NGW; const int t = t0 + (r < TG ? r : r0);
                        const float* xr = t < T_PROMPT ? p.x_prompt + (size_t)t * DM : p.x_sample + (size_t)(t - T_PROMPT) * DM;
#pragma unroll
                        for (int j = 0; j < 4; ++j) v[k][j] = *(const f32x4*)(xr + 256 * j + 4 * lane); }
                    asm volatile("" ::: "memory");
#pragma unroll
                    for (int k = 0; k < 4; ++k) { const int r = r0 + k * NGW; float s = 0.f;
#pragma unroll
                        for (int j = 0; j < 4; ++j) s += (v[k][j][0] * v[k][j][0] + v[k][j][1] * v[k][j][1]) + (v[k][j][2] * v[k][j][2] + v[k][j][3] * v[k][j][3]);
                        const float rs = __builtin_amdgcn_rsqf(wave_sum(s) * (1.f / DM) + EPS);
                        if (r < TG) {
#pragma unroll
                            for (int j = 0; j < 4; ++j) *(u32x2*)(H + (size_t)r * DM + 256 * j + 4 * lane) = pack4(v[k][j] * rs * gg[j]); } }
                }
                if (g == 1 && l == 0) FINAL_NORM(0, TG);
            } else if (sub == 1 && EN(1)) {
                pg8::Gemm gm{l == 0 ? H : XB, (const bf16_t*)(ws + WS_WIN + l * SZ_WIN), DM, DM, TG / 256, NV / 256, 1 << 20, 0, 1 << 20, 0, 0};
                pg8::StaticOrder S; S.init(gm.nM, gm.nN, G, bx);
                EpiIn E{Z, cosR, sinR, cosM, sinM, t0, l == 0 ? (const float*)nullptr : (const float*)RS1};
                pg8::gemm_phase<EpiIn>(lds, gm, S, E, tid);
                if (PROBE == 1) pg8::gemm_phase<EpiIn>(lds, gm, S, E, tid);
            } else if (sub == 2 && EN(2)) {
                for (int r0 = gw; r0 < TG; r0 += 8 * NGW) {
                    u32x2 a[8]; unsigned b[8];
#pragma unroll
                    for (int k = 0; k < 8; ++k) { const int r = r0 + k * NGW; const bf16_t* zr = Z + (size_t)(r < TG ? r : r0) * ZW;
                        a[k] = *(const u32x2*)(zr + C_CQ + 4 * lane); b[k] = *(const unsigned*)(zr + C_CKV + 2 * lane); }
                    asm volatile("" ::: "memory");
#pragma unroll
                    for (int k = 0; k < 8; ++k) { const int r = r0 + k * NGW;
                        float s1 = bf_lo(a[k].x) * bf_lo(a[k].x) + bf_hi(a[k].x) * bf_hi(a[k].x) + bf_lo(a[k].y) * bf_lo(a[k].y) + bf_hi(a[k].y) * bf_hi(a[k].y);
                        float s2 = bf_lo(b[k]) * bf_lo(b[k]) + bf_hi(b[k]) * bf_hi(b[k]);
                        s1 = wave_sum(s1); s2 = wave_sum(s2);
                        if (lane == 0 && r < TG) { RS[r * 2] = __builtin_amdgcn_rsqf(s1 * (1.f / 256.f) + EPS); RS[r * 2 + 1] = __builtin_amdgcn_rsqf(s2 * (1.f / 128.f) + EPS); } }
                }
                __syncthreads();
                for (int rep = (PROBE == 4 ? 0 : 1); rep < 2; ++rep)
                for (int u = vcu; u < (TG / 128) * 4; u += G) retA_unit(lds, Z, ST, u >> 2, u & 3, tid);
            } else if (sub == 3 && EN(3)) {
#define DO_QKV() do { pg8::Gemm gm{Z + C_CQ, (const bf16_t*)(ws + WS_WQKV + l * SZ_WQKV), ZW, KQKV, TG / 256, QW / 256, 1 << 20, 0, 3, (C_CKV - C_CQ) * 2, 2}; \
                    pg8::StaticOrder S; S.init(gm.nM, gm.nN, G, bx); EpiQKV E{QKV, RS, cosM, sinM, t0}; pg8::gemm_phase<EpiQKV>(lds, gm, S, E, tid); } while (0)
                if (vcu & 1) { ret_scan(ST, g, gtid, gthreads); asm volatile("" : "+v"(tid)); DO_QKV(); }
                else { DO_QKV(); asm volatile("" : "+v"(tid)); ret_scan(ST, g, gtid, gthreads); }
            } else if (sub == 4 && (EN(4) || EN(8))) {
#define DO_RETO() do { const float* gng = p.ret_gn_g + l * 512; for (int u = vcu; u < (TG / 128) * 4; u += G) retO_unit(lds, Z, ST, gng, u >> 2, u & 3, tid, true); } while (0)
#define DO_ATTN() do { const int n_prompt_units = (g == 0 ? 24 : 8) * 32, n_units = n_prompt_units + (g == 0 ? 0 : 8 * 64); \
                    for (int u = vcu; u < n_units; u += G) { int row0, seqlen, head, qb; \
                        if (u < n_prompt_units) { const int s = u >> 5, rem = u & 31; head = rem >> 3; qb = rem & 7; row0 = s * 2048; seqlen = 2048; } \
                        else { const int uu = u - n_prompt_units; const int s = uu >> 6, rem = uu & 63; head = rem >> 4; qb = rem & 15; row0 = (T_PROMPT - t0) + s * 4096; seqlen = 4096; } \
                        const bf16_t* kv = QKV + (size_t)row0 * QW + 768 + head * 256; \
                        att::attn_unit(QKV + (size_t)(row0 + qb * 256) * QW + head * 192, kv, kv + 128, Z + (size_t)row0 * ZW + C_KPE, \
                                       Z + (size_t)(row0 + qb * 256) * ZW + C_MG + head * 128, seqlen, lds, tid, wave_s, true); } } while (0)
                if (vcu & 1) { DO_ATTN(); asm volatile("" : "+v"(tid)); DO_RETO(); }
                else { DO_RETO(); asm volatile("" : "+v"(tid)); DO_ATTN(); }
            } else if (sub == 5 && EN(5)) {
                pg8::Gemm gm{Z + C_RG, (const bf16_t*)(ws + WS_WBR + l * 2 * SZ_WBR), ZW, 1024, TG / 256, 4, 8, (C_MG - C_RG - 512) * 2, 1 << 20, 0, 0};
                pg8::StaticOrder S; S.init(gm.nM, gm.nN, G, bx);
                EpiBr E{Z};
                pg8::gemm_phase<EpiBr>(lds, gm, S, E, tid);
            } else if (sub == 6 && EN(7)) {
                pg8::Gemm gm{Z, (const bf16_t*)(ws + WS_WOUT + l * SZ_WOUT), ZW, 1024, TG / 256, 4, 1 << 20, 0, 1 << 20, 0, 0};
                pg8::StaticOrder S; S.init(gm.nM, gm.nN, G, bx);
                if (l == 0) { EpiOut0 E{p.x_prompt, p.x_sample, XB, SSQ, t0}; pg8::gemm_phase<EpiOut0>(lds, gm, S, E, tid); }
                else { EpiOut1 E{XB, SSQ}; pg8::gemm_phase<EpiOut1>(lds, gm, S, E, tid); }
            }
        }
        if (ph + 1 < p.ph_hi) { if (p.ph_hi < 0) grid.sync(); else { XcdBarrier xb2; xb2.bar = (unsigned*)(p.ws + WS_CTL); xb2.x = xb_xcc_id(); xb2.st = (volatile LAS unsigned*)(lds + LDS_BYTES - 16); int n1b = -1; asm volatile("" : "+s"(n1b)); xcd_barrier(xb2, wave_s == 0 && __builtin_amdgcn_mbcnt_hi(n1b, __builtin_amdgcn_mbcnt_lo(n1b, 0)) == 0); } }
    }
}

extern "C" void kernel_launch(void* const* d_in, const int* in_sizes, int n_in, void* d_out, int out_size, void* d_ws, size_t ws_size, hipStream_t stream) {
    static int grid_blocks = 0;
    if (!grid_blocks) {
        int dev = 0, cus = 0, per_cu = 0;
        hipGetDevice(&dev);
        hipDeviceGetAttribute(&cus, hipDeviceAttributeMultiprocessorCount, dev);
        hipFuncSetAttribute((const void*)mega_fwd, hipFuncAttributeMaxDynamicSharedMemorySize, LDS_BYTES);
        hipOccupancyMaxActiveBlocksPerMultiprocessor(&per_cu, (const void*)mega_fwd, 512, LDS_BYTES);
        if (per_cu < 1) { fprintf(stderr, "kernel_launch: occupancy query says %d blocks/CU\n", per_cu); per_cu = 1; }
        grid_blocks = cus * per_cu;
        if (ws_size < WS_END) fprintf(stderr, "kernel_launch: workspace too small: %zu < %zu\n", ws_size, (size_t)WS_END);
    }
    Params p{};
    p.x_prompt = (const float*)d_in[0]; p.x_sample = (const float*)d_in[1]; p.norm_g = (const float*)d_in[2]; p.w_in = (const float*)d_in[3];
    p.ret_gn_g = (const float*)d_in[4]; p.q_norm_g = (const float*)d_in[5]; p.kv_norm_g = (const float*)d_in[6]; p.w_uq = (const float*)d_in[7];
    p.w_ukv = (const float*)d_in[8]; p.w_br_ret = (const float*)d_in[9]; p.w_br_mla = (const float*)d_in[10]; p.w_out = (const float*)d_in[11];
    p.final_norm_g = (const float*)d_in[12]; p.out = (float*)d_out; p.ws = (unsigned char*)d_ws;
#if MK_MULTI
    for (int ph = 0; ph < N_PHASES; ++ph) {
        p.ph_lo = ph; p.ph_hi = ph + 1;
        hipLaunchKernelGGL(mega_fwd, dim3(grid_blocks), dim3(512), LDS_BYTES, stream, p);
    }
#else
    p.ph_lo = 0; p.ph_hi = N_PHASES;
    if (hipMemsetAsync((char*)d_ws + WS_CTL, 0, CTL_BYTES, stream) != hipSuccess) fprintf(stderr, "memset failed\n");
    void* args[] = {&p};
    hipError_t e = hipLaunchCooperativeKernel((const void*)mega_fwd, dim3(grid_blocks), dim3(512), args, LDS_BYTES, stream);
    if (e != hipSuccess) fprintf(stderr, "cooperative launch failed: %s (grid %d)\n", hipGetErrorString(e), grid_blocks);
#endif
}
```
